# Optimizing an MI355X kernel written in HIP

```python
import math
import jax, jax.numpy as jnp
from jax import lax
import numpy as np

D_MODEL = 2048
BATCH = 8
SEQ = 2048
DEPTH = 2

GRID_W = 64
CTX_LEN = 256
N_GROUPS = 4
GROUP_W = D_MODEL // N_GROUPS
MIX_W = N_GROUPS * GROUP_W
HEAD_DIM = 64
CONV_A_WIDTH = 31
DIFF_HEADS = GROUP_W // (2 * HEAD_DIM)
ROPE_BASE = 10000.0
Q_BLOCK = 128
CONV_C_WIDTH = 3
LRU_BLOCKS = GROUP_W // HEAD_DIM
LRU_CONV_WIDTH = 4
LRU_C = 8.0
N_EXPERTS = 32
TOP_K = 4
D_FF = D_MODEL // 2
SWIGLU_LIMIT = 7.0
SWIGLU_ALPHA = 1.702
EPS = 1e-6
COLS_A = 2 * GROUP_W
COLS_B = 3 * GROUP_W
COLS_C = 3 * GROUP_W
COLS_D = 2 * GROUP_W
N_IN = COLS_A + COLS_B + COLS_C + COLS_D
COL_SPLITS = (COLS_A, COLS_A + COLS_B, COLS_A + COLS_B + COLS_C)
F32 = jnp.float32

kernel_name = 'hybrid_parallel_groups_moe_dit_block'


def rms_norm(x, g):
    xf = x.astype(F32)
    y = xf * lax.rsqrt(jnp.mean(xf * xf, axis=-1, keepdims=True) + EPS)
    return (y * g).astype(x.dtype)


def layer_norm(x, g, b):
    xf = x.astype(F32)
    mu = jnp.mean(xf, axis=-1, keepdims=True)
    var = jnp.mean(jnp.square(xf - mu), axis=-1, keepdims=True)
    return ((xf - mu) * lax.rsqrt(var + EPS) * g + b).astype(x.dtype)


def depthwise_conv(x, w, pad):
    return lax.conv_general_dilated(
        x, w[:, None, :].astype(x.dtype), (1,), [pad],
        dimension_numbers=('NWC', 'WIO', 'NWC'), feature_group_count=x.shape[-1])


def axial_rope_tables(seq_len):
    rows = seq_len // GRID_W
    row = jnp.repeat(jnp.arange(rows, dtype=F32), GRID_W)
    col = jnp.tile(jnp.arange(GRID_W, dtype=F32), rows)
    half = HEAD_DIM // 2
    inv = ROPE_BASE ** (-jnp.arange(0, half, 2, dtype=F32) / half)
    ar = row[:, None] * inv
    ac = col[:, None] * inv
    ang = jnp.concatenate([ar, ar, ac, ac], axis=-1)
    return jnp.cos(ang), jnp.sin(ang)


def apply_axial_rope(x, cos, sin):
    xf = x.astype(F32)
    x1, x2, x3, x4 = jnp.split(xf, 4, axis=-1)
    rot = jnp.concatenate([-x2, x1, -x4, x3], axis=-1)
    return (xf * cos[:, None, :] + rot * sin[:, None, :]).astype(x.dtype)


def conformer_conv(u, conv_w, conv_b, ln_g, ln_b):
    val, gate = jnp.split(u, 2, axis=-1)
    z = val * jax.nn.sigmoid(gate)
    half = (CONV_A_WIDTH - 1) // 2
    z = depthwise_conv(z, conv_w, (half, half)) + conv_b
    return jax.nn.silu(layer_norm(z, ln_g, ln_b))


def split_diff_heads(u):
    bsz, n, _ = u.shape
    q, k, v = jnp.split(u, 3, axis=-1)
    return (q.reshape(bsz, n, 2 * DIFF_HEADS, HEAD_DIM),
            k.reshape(bsz, n, 2 * DIFF_HEADS, HEAD_DIM),
            v.reshape(bsz, n, DIFF_HEADS, 2 * HEAD_DIM))


def diff_softmax_attend(q, k, v, lam):
    s = jnp.einsum('bqhd,bkhd->bhqk', q, k).astype(F32) * (HEAD_DIM ** -0.5)
    p = jax.nn.softmax(s, axis=-1)
    bsz, _, lq, lk = p.shape
    p = p.reshape(bsz, DIFF_HEADS, 2, lq, lk)
    w = (p[:, :, 0] - lam * p[:, :, 1]).astype(v.dtype)
    return jnp.einsum('bhqk,bkhe->bqhe', w, v)


def diff_head_norm(o, g, lam_init):
    o = rms_norm(o, g) * (1.0 - lam_init)
    return o.reshape(o.shape[0], o.shape[1], DIFF_HEADS * 2 * HEAD_DIM)


def diff_attention(ub, cb, lam_vecs, norm_g, lam_init, cos, sin, need_ctx):
    q, k, v = split_diff_heads(ub)
    qc, kc, vc = split_diff_heads(cb)
    q = apply_axial_rope(q, cos, sin)
    k = apply_axial_rope(k, cos, sin)
    lv = lam_vecs.astype(F32)
    lam = jnp.exp(jnp.sum(lv[0] * lv[1])) - jnp.exp(jnp.sum(lv[2] * lv[3])) + lam_init
    k_all = jnp.concatenate([kc, k], axis=1)
    v_all = jnp.concatenate([vc, v], axis=1)
    bsz, seq_len = q.shape[0], q.shape[1]
    n_blk = seq_len // Q_BLOCK
    q_blocks = q.reshape(bsz, n_blk, Q_BLOCK, 2 * DIFF_HEADS, HEAD_DIM).swapaxes(0, 1)
    o = lax.map(lambda qb: diff_softmax_attend(qb, k_all, v_all, lam), q_blocks)
    o = o.swapaxes(0, 1).reshape(bsz, seq_len, DIFF_HEADS, 2 * HEAD_DIM)
    y = diff_head_norm(o, norm_g, lam_init)
    y_ctx = diff_head_norm(diff_softmax_attend(qc, kc, vc, lam), norm_g, lam_init) if need_ctx else None
    return y, y_ctx


def gated_short_conv(u, conv_w, norm_g):
    bg, cg, v = jnp.split(u, 3, axis=-1)
    half = (CONV_C_WIDTH - 1) // 2
    y = bg * depthwise_conv(cg * v, conv_w, (half, half))
    return rms_norm(y, norm_g)


def linear_scan(a, b, h0, reverse):
    idx = -1 if reverse else 0
    b = b.at[:, idx].add(a[:, idx] * h0)

    def combine(left, right):
        a_l, b_l = left
        a_r, b_r = right
        return a_l * a_r, a_r * b_l + b_r

    _, h = lax.associative_scan(combine, (a, b), reverse=reverse, axis=1)
    return h


def rglru_direction(xr, conv_w, conv_b, wa, ba, wx, bx, lam, h0, reverse):
    pad = (0, LRU_CONV_WIDTH - 1) if reverse else (LRU_CONV_WIDTH - 1, 0)
    xcv = depthwise_conv(xr, conv_w, pad) + conv_b
    bsz, n, w = xcv.shape
    xh = xcv.reshape(bsz, n, LRU_BLOCKS, w // LRU_BLOCKS)
    r = jax.nn.sigmoid(jnp.einsum('blhi,hij->blhj', xh, wa).reshape(bsz, n, w) + ba)
    ig = jax.nn.sigmoid(jnp.einsum('blhi,hij->blhj', xh, wx).reshape(bsz, n, w) + bx)
    log_a = -LRU_C * r.astype(F32) * jax.nn.softplus(-lam.astype(F32))
    a = jnp.exp(log_a)
    b = jnp.sqrt(-jnp.expm1(2.0 * log_a)) * (ig * xcv).astype(F32)
    h = linear_scan(a, b, h0, reverse)
    h_last = h[:, 0] if reverse else h[:, -1]
    return h, h_last


def bidir_rglru(ud, cd, conv_w, conv_b, wa, ba, wx, bx, lam, norm_g, need_ctx):
    gate_l, rec_l = jnp.split(ud, 2, axis=-1)
    gate_c, rec_c = jnp.split(cd, 2, axis=-1)
    h0 = jnp.zeros((cd.shape[0], GROUP_W), F32)
    out_l = jnp.zeros(rec_l.shape, F32)
    out_c = jnp.zeros(rec_c.shape, F32)
    for d in range(2):
        rev = d == 1
        prm = (conv_w[d], conv_b[d], wa[d], ba[d], wx[d], bx[d], lam[d])
        hs_c, h_ctx_final = rglru_direction(rec_c, *prm, h0, rev)
        hs_l, _ = rglru_direction(rec_l, *prm, h_ctx_final, rev)
        out_l = out_l + hs_l
        out_c = out_c + hs_c
    y = rms_norm(jax.nn.gelu(gate_l) * out_l.astype(ud.dtype), norm_g)
    y_ctx = rms_norm(jax.nn.gelu(gate_c) * out_c.astype(cd.dtype), norm_g) if need_ctx else None
    return y, y_ctx


def token_mixers(h, hc, w_in, w_out, conv_a_w, conv_a_b, ln_a_g, ln_a_b, diff_lambda, diff_norm_g,
                 conv_c_w, norm_c_g, lru_conv_w, lru_conv_b, lru_wa, lru_ba, lru_wx, lru_bx,
                 lru_lam, norm_d_g, cos, sin, lam_init, need_ctx):
    ua, ub, us, ud = jnp.split(h @ w_in, COL_SPLITS, axis=-1)
    ca, cb, cs, cd = jnp.split(hc @ w_in, COL_SPLITS, axis=-1)
    ya = conformer_conv(ua, conv_a_w, conv_a_b, ln_a_g, ln_a_b)
    yb, yb_c = diff_attention(ub, cb, diff_lambda, diff_norm_g, lam_init, cos, sin, need_ctx)
    ys = gated_short_conv(us, conv_c_w, norm_c_g)
    yd, yd_c = bidir_rglru(ud, cd, lru_conv_w, lru_conv_b, lru_wa, lru_ba, lru_wx, lru_bx,
                           lru_lam, norm_d_g, need_ctx)
    y = jnp.concatenate([ya, yb, ys, yd], axis=-1) @ w_out
    y_ctx = None
    if need_ctx:
        ya_c = conformer_conv(ca, conv_a_w, conv_a_b, ln_a_g, ln_a_b)
        ys_c = gated_short_conv(cs, conv_c_w, norm_c_g)
        y_ctx = jnp.concatenate([ya_c, yb_c, ys_c, yd_c], axis=-1) @ w_out
    return y, y_ctx


def moe_ffn(t, router_w, router_b, w1, b1, w2, b2):
    logits = (t @ router_w + router_b).astype(F32)
    top_v, top_i = lax.top_k(logits, TOP_K)
    gates = jax.nn.softmax(top_v, axis=-1)
    combine = jnp.einsum('tk,tke->te', gates, jax.nn.one_hot(top_i, N_EXPERTS, dtype=F32))
    acc = jnp.zeros(t.shape, F32)
    for e in range(N_EXPERTS):
        gu = t @ w1[e] + b1[e]
        g = jnp.minimum(gu[:, 0::2], SWIGLU_LIMIT)
        up = jnp.clip(gu[:, 1::2], -SWIGLU_LIMIT, SWIGLU_LIMIT)
        act = (up + 1.0) * (g * jax.nn.sigmoid(SWIGLU_ALPHA * g))
        acc = acc + combine[:, e:e + 1] * (act @ w2[e] + b2[e]).astype(F32)
    return acc.astype(t.dtype)


def setup_inputs(seed: int = 0) -> dict:
    key = jax.random.key(seed)
    ks = iter(jax.random.split(key, 48))

    def nrm(shape, s):
        return jax.random.normal(next(ks), shape, F32) * s

    L = DEPTH
    u = jax.random.uniform(next(ks), (L, 2, GROUP_W), F32, 0.9, 0.999)
    a = u ** (1.0 / LRU_C)
    lru_lam = jnp.log(a) - jnp.log1p(-a)
    return {
        'x': nrm((BATCH, SEQ, D_MODEL), 1.0),
        'c': nrm((BATCH, D_MODEL), 1.0),
        'ctx': nrm((BATCH, CTX_LEN, D_MODEL), 1.0),
        'c_ctx': nrm((D_MODEL,), 1.0),
        'ada_w': nrm((L, D_MODEL, 6 * D_MODEL), 0.5 * D_MODEL ** -0.5),
        'ada_b': nrm((L, 6 * D_MODEL), 0.02),
        'norm1_g': 1.0 + nrm((L, D_MODEL), 0.02),
        'norm2_g': 1.0 + nrm((L, D_MODEL), 0.02),
        'w_in': nrm((L, D_MODEL, N_IN), D_MODEL ** -0.5),
        'w_out': nrm((L, MIX_W, D_MODEL), MIX_W ** -0.5),
        'conv_a_w': nrm((L, CONV_A_WIDTH, GROUP_W), CONV_A_WIDTH ** -0.5),
        'conv_a_b': nrm((L, GROUP_W), 0.02),
        'ln_a_g': 1.0 + nrm((L, GROUP_W), 0.02),
        'ln_a_b': nrm((L, GROUP_W), 0.02),
        'diff_lambda': nrm((L, 4, HEAD_DIM), 0.1),
        'diff_norm_g': 1.0 + nrm((L, 2 * HEAD_DIM), 0.02),
        'conv_c_w': nrm((L, CONV_C_WIDTH, GROUP_W), CONV_C_WIDTH ** -0.5),
        'norm_c_g': 1.0 + nrm((L, GROUP_W), 0.02),
        'lru_conv_w': nrm((L, 2, LRU_CONV_WIDTH, GROUP_W), LRU_CONV_WIDTH ** -0.5),
        'lru_conv_b': nrm((L, 2, GROUP_W), 0.02),
        'lru_wa': nrm((L, 2, LRU_BLOCKS, HEAD_DIM, HEAD_DIM), HEAD_DIM ** -0.5),
        'lru_ba': nrm((L, 2, GROUP_W), 0.02),
        'lru_wx': nrm((L, 2, LRU_BLOCKS, HEAD_DIM, HEAD_DIM), HEAD_DIM ** -0.5),
        'lru_bx': nrm((L, 2, GROUP_W), 0.02),
        'lru_lam': lru_lam,
        'norm_d_g': 1.0 + nrm((L, GROUP_W), 0.02),
        'router_w': nrm((L, D_MODEL, N_EXPERTS), D_MODEL ** -0.5),
        'router_b': nrm((L, N_EXPERTS), 0.01),
        'exp_w1': nrm((L, N_EXPERTS, D_MODEL, 2 * D_FF), D_MODEL ** -0.5),
        'exp_b1': nrm((L, N_EXPERTS, 2 * D_FF), 0.02),
        'exp_w2': nrm((L, N_EXPERTS, D_FF, D_MODEL), D_FF ** -0.5),
        'exp_b2': nrm((L, N_EXPERTS, D_MODEL), 0.02),
        'final_g': 1.0 + nrm((D_MODEL,), 0.02),
    }


def reference(x, c, ctx, c_ctx, ada_w, ada_b, norm1_g, norm2_g, w_in, w_out,
              conv_a_w, conv_a_b, ln_a_g, ln_a_b, diff_lambda, diff_norm_g,
              conv_c_w, norm_c_g, lru_conv_w, lru_conv_b, lru_wa, lru_ba, lru_wx,
              lru_bx, lru_lam, norm_d_g, router_w, router_b, exp_w1, exp_b1,
              exp_w2, exp_b2, final_g):
    bsz, seq_len, _ = x.shape
    cos, sin = axial_rope_tables(seq_len)
    xc = ctx
    for i in range(DEPTH):
        need_ctx = i < DEPTH - 1
        lam_init = 0.8 - 0.6 * math.exp(-0.3 * i)
        mod = jax.nn.silu(c) @ ada_w[i] + ada_b[i]
        mod_c = jax.nn.silu(c_ctx) @ ada_w[i] + ada_b[i]
        sh1, sc1, g1, sh2, sc2, g2 = jnp.split(mod[:, None, :], 6, axis=-1)
        csh1, csc1, cg1, csh2, csc2, cg2 = jnp.split(mod_c, 6, axis=-1)
        h = rms_norm(x, norm1_g[i]) * (1.0 + sc1) + sh1
        hc = rms_norm(xc, norm1_g[i]) * (1.0 + csc1) + csh1
        y, y_ctx = token_mixers(h, hc, w_in[i], w_out[i], conv_a_w[i], conv_a_b[i], ln_a_g[i], ln_a_b[i],
                                diff_lambda[i], diff_norm_g[i], conv_c_w[i], norm_c_g[i],
                                lru_conv_w[i], lru_conv_b[i], lru_wa[i], lru_ba[i], lru_wx[i], lru_bx[i],
                                lru_lam[i], norm_d_g[i], cos, sin, lam_init, need_ctx)
        x = x + g1 * y
        h2 = rms_norm(x, norm2_g[i]) * (1.0 + sc2) + sh2
        moe_args = (router_w[i], router_b[i], exp_w1[i], exp_b1[i], exp_w2[i], exp_b2[i])
        if need_ctx:
            xc = xc + cg1 * y_ctx
            hc2 = rms_norm(xc, norm2_g[i]) * (1.0 + csc2) + csh2
            n_lat = bsz * seq_len
            tokens = jnp.concatenate([h2.reshape(n_lat, D_MODEL), hc2.reshape(-1, D_MODEL)], axis=0)
            f = moe_ffn(tokens, *moe_args)
            x = x + g2 * f[:n_lat].reshape(x.shape)
            xc = xc + cg2 * f[n_lat:].reshape(xc.shape)
        else:
            x = x + g2 * moe_ffn(h2.reshape(-1, D_MODEL), *moe_args).reshape(x.shape)
    return rms_norm(x, final_g)
```

```cpp
#include <hip/hip_runtime.h>
#include <cstdio>

typedef unsigned short bf16_t;
#define LAS __attribute__((address_space(3)))
typedef LAS float lfloat;
typedef float f32x4 __attribute__((ext_vector_type(4)));
typedef LAS f32x4 lf32x4;
__device__ __forceinline__ float4 lds_ld4(const lfloat* p) { const f32x4 v = *(const lf32x4*)p; return make_float4(v.x, v.y, v.z, v.w); }
__device__ __forceinline__ void lds_st4(lfloat* p, float4 v) { *(lf32x4*)p = (f32x4){v.x, v.y, v.z, v.w}; }
typedef LAS int lint;

constexpr int D = 2048, NB = 8, SEQ = 2048, CTXL = 256;
constexpr int TL = NB * SEQ;
constexpr int TC = NB * CTXL;
constexpr int MT = TL + TC;
constexpr int NIN = 5120, GW = 512, NE = 32, DFF = 1024;
constexpr int MODW = 6 * D;
constexpr int NSLOT = 81920;
constexpr float EPS = 1e-6f;
constexpr int NKC = 16;
constexpr int NCHUNK = 72;

enum { I_X = 0, I_C, I_CTX, I_CCTX, I_ADAW, I_ADAB, I_N1G, I_N2G, I_WIN, I_WOUT, I_CAW, I_CAB, I_LNAG, I_LNAB, I_DLAM, I_DNG, I_CCW, I_NCG,
       I_LCW, I_LCB, I_LWA, I_LBA, I_LWX, I_LBX, I_LLAM, I_NDG, I_RW, I_RB, I_W1, I_B1, I_W2, I_B2, I_FG, N_INPUTS };

constexpr size_t MiB = 1ull << 20;
constexpr size_t WS_CTL = 0, CTL_BYTES = 1 * MiB;
constexpr size_t WS_MODP = 1 * MiB;
constexpr size_t WS_MOD = 17 * MiB;
constexpr size_t WS_H = 18 * MiB;
constexpr size_t WS_U = 90 * MiB;
constexpr size_t WS_YM = 270 * MiB;
constexpr size_t WS_XA = 342 * MiB;
constexpr size_t WS_XB = 486 * MiB;
constexpr size_t WS_SP = 630 * MiB;
constexpr size_t WS_TOPI = 636 * MiB;
constexpr size_t WS_GATE = 637 * MiB;
constexpr size_t WS_TSLOT = 638 * MiB;
constexpr size_t WS_STOK = 639 * MiB;
constexpr size_t WS_ACT = 640 * MiB;
constexpr size_t WS_OS = 800 * MiB;
constexpr size_t WS_END = 1120 * MiB;
constexpr int CW_CNT = 64;
constexpr int CW_FILL = 192;

constexpr int LDS_BYTES = 147456;
constexpr int LDS_MISC = 131072;

struct Params { const float* in[N_INPUTS]; float* out; unsigned char* ws; int ph_lo, ph_hi; };

__device__ __forceinline__ float bf2f(bf16_t h) { return __uint_as_float(((unsigned)h) << 16); }
__device__ __forceinline__ unsigned f2bf(float f) { unsigned u = __float_as_uint(f); return (u + 0x7fffu + ((u >> 16) & 1u)) >> 16; }
__device__ __forceinline__ unsigned pk2(float lo, float hi) { return f2bf(lo) | (f2bf(hi) << 16); }
__device__ __forceinline__ float sigmoidf_(float x) { return 1.f / (1.f + __expf(-x)); }
__device__ __forceinline__ float wave_sum(float v) {
#pragma unroll
    for (int o = 1; o < 64; o <<= 1) v += __shfl_xor(v, o);
    return v;
}
__device__ __forceinline__ float wave_max(float v) {
#pragma unroll
    for (int o = 1; o < 64; o <<= 1) v = fmaxf(v, __shfl_xor(v, o));
    return v;
}
template <int R> __device__ __forceinline__ void block_rowsum(float (&v)[R], lfloat* red, int wave, int lane) {
#pragma unroll
    for (int r = 0; r < R; ++r) { const float s = wave_sum(v[r]); if (lane == 0) red[wave * R + r] = s; }
    __syncthreads();
#pragma unroll
    for (int r = 0; r < R; ++r) { float s = 0.f;
#pragma unroll
        for (int w = 0; w < 8; ++w) s += red[w * R + r];
        v[r] = s; }
    __syncthreads();
}

struct Ctx {
    const float* const* in; float* out; unsigned char* ws;
    int tid, lane, wave, bid, nb;
    LAS unsigned char* lds;
    __device__ __forceinline__ const float* I(int i) const { return in[i]; }
    __device__ __forceinline__ float* mod() const { return (float*)(ws + WS_MOD); }
    __device__ __forceinline__ bf16_t* H() const { return (bf16_t*)(ws + WS_H); }
    __device__ __forceinline__ bf16_t* U() const { return (bf16_t*)(ws + WS_U); }
    __device__ __forceinline__ bf16_t* YM() const { return (bf16_t*)(ws + WS_YM); }
    __device__ __forceinline__ float* XA() const { return (float*)(ws + WS_XA); }
    __device__ __forceinline__ float* XB() const { return (float*)(ws + WS_XB); }
    __device__ __forceinline__ unsigned* ctl() const { return (unsigned*)(ws + WS_CTL); }
};

__device__ __forceinline__ const float* xsrc_row(const Ctx& c, int l, int r) {
    if (l == 0) return (r < TL) ? c.I(I_X) + (size_t)r * D : c.I(I_CTX) + (size_t)(r - TL) * D;
    return c.XB() + (size_t)r * D;
}
__device__ __forceinline__ int mod_row(int r) { return r < TL ? r / SEQ : 8; }

__device__ __forceinline__ void ph_mod_partial(const Ctx& c) {
    lfloat* sl = (lfloat*)c.lds;
    float* modp = (float*)(c.ws + WS_MODP);
    for (int it = c.bid; it < 2 * NKC * 6; it += c.nb) {
        const int l = it / (NKC * 6), rem = it % (NKC * 6), kc = rem / 6, cg = rem % 6;
        const int k0 = kc * 128, col = cg * 2048 + c.tid * 4;
        for (int i = c.tid; i < 9 * 128; i += 512) { const int r = i >> 7, k = i & 127; const float cv = (r < 8) ? c.I(I_C)[r * D + k0 + k] : c.I(I_CCTX)[k0 + k]; sl[i] = cv * sigmoidf_(cv); }
        __syncthreads();
        float acc[9][4];
#pragma unroll
        for (int r = 0; r < 9; ++r)
#pragma unroll
            for (int q = 0; q < 4; ++q) acc[r][q] = 0.f;
        const float* wp = c.I(I_ADAW) + ((size_t)l * D + k0) * MODW + col;
#pragma unroll 4
        for (int k = 0; k < 128; ++k) {
            const float4 w = *(const float4*)(wp + (size_t)k * MODW);
#pragma unroll
            for (int r = 0; r < 9; ++r) { const float s = sl[r * 128 + k]; acc[r][0] += s * w.x; acc[r][1] += s * w.y; acc[r][2] += s * w.z; acc[r][3] += s * w.w; }
        }
#pragma unroll
        for (int r = 0; r < 9; ++r) *(float4*)(modp + ((size_t)(l * NKC + kc) * 9 + r) * MODW + col) = make_float4(acc[r][0], acc[r][1], acc[r][2], acc[r][3]);
        __syncthreads();
    }
}
__device__ __forceinline__ void ph_mod_reduce(const Ctx& c) {
    const float* modp = (const float*)(c.ws + WS_MODP);
    float* mod = c.mod();
    for (int i = c.bid * 512 + c.tid; i < 2 * 9 * MODW; i += c.nb * 512) {
        const int l = i / (9 * MODW), rem = i % (9 * MODW), r = rem / MODW, n = rem % MODW;
        float s = c.I(I_ADAB)[l * MODW + n];
        for (int kc = 0; kc < NKC; ++kc) s += modp[((size_t)(l * NKC + kc) * 9 + r) * MODW + n];
        mod[i] = s;
    }
}

__device__ __forceinline__ void ph_norm1(const Ctx& c, int l) {
    const float* g = c.I(I_N1G) + l * D;
    for (int r = c.bid * 8 + c.wave; r < MT; r += c.nb * 8) {
        const float4* src = (const float4*)xsrc_row(c, l, r);
        float4 v[8]; float ss = 0.f;
#pragma unroll
        for (int j = 0; j < 8; ++j) { v[j] = src[j * 64 + c.lane]; ss += v[j].x * v[j].x + v[j].y * v[j].y + v[j].z * v[j].z + v[j].w * v[j].w; }
        const float rstd = rsqrtf(wave_sum(ss) * (1.f / D) + EPS);
        const float* m = c.mod() + (size_t)(l * 9 + mod_row(r)) * MODW;
        bf16_t* o = c.H() + (size_t)r * D;
#pragma unroll
        for (int j = 0; j < 8; ++j) {
            const int col = (j * 64 + c.lane) * 4;
            const float4 gg = *(const float4*)(g + col), sc = *(const float4*)(m + 1 * D + col), sh = *(const float4*)(m + 0 * D + col);
            const float o0 = v[j].x * rstd * gg.x * (1.f + sc.x) + sh.x, o1 = v[j].y * rstd * gg.y * (1.f + sc.y) + sh.y;
            const float o2 = v[j].z * rstd * gg.z * (1.f + sc.z) + sh.z, o3 = v[j].w * rstd * gg.w * (1.f + sc.w) + sh.w;
            *(uint2*)(o + col) = make_uint2(pk2(o0, o1), pk2(o2, o3));
        }
    }
}

template <class Epi>
__device__ __forceinline__ void ngemm_tile(const Ctx& c, const bf16_t* A, const int* ridx, int row0, const float* B, int ldb, int col0, int K, const Epi& epi) {
    lfloat* As = (lfloat*)c.lds;
    lfloat* Bs = As + 16 * 128;
    const int tid = c.tid, tx = tid & 31, ty = tid >> 5;
    float acc[8][4];
#pragma unroll
    for (int i = 0; i < 8; ++i)
#pragma unroll
        for (int q = 0; q < 4; ++q) acc[i][q] = 0.f;
    const int ar = tid >> 2, ak = (tid & 3) * 4;
    const size_t arow = ridx ? (size_t)ridx[row0 + ar] : (size_t)(row0 + ar);
    const bf16_t* ap = A + arow * K + ak;
    const float* bp = B + (size_t)(tid >> 5) * ldb + col0 + (tid & 31) * 4;
    for (int k0 = 0; k0 < K; k0 += 16) {
        const uint2 av = *(const uint2*)(ap + k0);
        const float4 bv = *(const float4*)(bp + (size_t)k0 * ldb);
        __syncthreads();
        As[(ak + 0) * 128 + ar] = __uint_as_float(av.x << 16); As[(ak + 1) * 128 + ar] = __uint_as_float(av.x & 0xffff0000u);
        As[(ak + 2) * 128 + ar] = __uint_as_float(av.y << 16); As[(ak + 3) * 128 + ar] = __uint_as_float(av.y & 0xffff0000u);
        lds_st4(Bs + (tid >> 5) * 128 + (tid & 31) * 4, bv);
        __syncthreads();
#pragma unroll
        for (int k = 0; k < 16; ++k) {
            const float4 a0 = lds_ld4(As + k * 128 + ty * 8), a1 = lds_ld4(As + k * 128 + ty * 8 + 4);
            const float4 b = lds_ld4(Bs + k * 128 + tx * 4);
            const float a[8] = {a0.x, a0.y, a0.z, a0.w, a1.x, a1.y, a1.z, a1.w};
#pragma unroll
            for (int i = 0; i < 8; ++i) { acc[i][0] += a[i] * b.x; acc[i][1] += a[i] * b.y; acc[i][2] += a[i] * b.z; acc[i][3] += a[i] * b.w; }
        }
    }
#pragma unroll
    for (int i = 0; i < 8; ++i) epi(row0 + ty * 8 + i, col0 + tx * 4, acc[i][0], acc[i][1], acc[i][2], acc[i][3]);
    __syncthreads();
}

struct EpiU { bf16_t* U;
    __device__ __forceinline__ void operator()(int row, int col, float a, float b, float cc, float d) const { *(uint2*)(U + (size_t)row * NIN + col) = make_uint2(pk2(a, b), pk2(cc, d)); } };
struct EpiX1 { const Ctx* c; int l; float* X1;
    __device__ __forceinline__ void operator()(int row, int col, float a, float b, float cc, float d) const {
        const float4 g1 = *(const float4*)(c->mod() + (size_t)(l * 9 + mod_row(row)) * MODW + 2 * D + col);
        const float4 xi = *(const float4*)(xsrc_row(*c, l, row) + col);
        *(float4*)(X1 + (size_t)row * D + col) = make_float4(xi.x + g1.x * a, xi.y + g1.y * b, xi.z + g1.z * cc, xi.w + g1.w * d); } };
__device__ __forceinline__ float swiglu_act(float g, float up) {
    g = fminf(g, 7.f); up = fminf(fmaxf(up, -7.f), 7.f);
    return (up + 1.f) * (g * sigmoidf_(1.702f * g));
}
struct EpiAct { const float* b1e; bf16_t* ACT;
    __device__ __forceinline__ void operator()(int row, int col, float a, float b, float cc, float d) const {
        const float4 bb = *(const float4*)(b1e + col);
        const float x0 = swiglu_act(a + bb.x, b + bb.y), x1 = swiglu_act(cc + bb.z, d + bb.w);
        *(unsigned*)(ACT + (size_t)row * DFF + (col >> 1)) = pk2(x0, x1); } };
struct EpiOS { const float* b2e; bf16_t* OS;
    __device__ __forceinline__ void operator()(int row, int col, float a, float b, float cc, float d) const {
        const float4 bb = *(const float4*)(b2e + col);
        *(uint2*)(OS + (size_t)row * D + col) = make_uint2(pk2(a + bb.x, b + bb.y), pk2(cc + bb.z, d + bb.w)); } };

__device__ __forceinline__ bool win_tile_needed(int l, int rt128, int ct128) {
    if (l == 0) return true;
    if (rt128 < TL / 128) return true;
    const int col = ct128 * 128;
    return (col >= 1536 && col < 2560) || (col >= 4608);
}
__device__ __forceinline__ void ph_gemm_in(const Ctx& c, int l) {
    const EpiU E{c.U()};
    const float* B = c.I(I_WIN) + (size_t)l * D * NIN;
    const int nct = NIN / 128, total = (MT / 128) * nct;
    for (int it = c.bid; it < total; it += c.nb) {
        const int rt = it / nct, ct = it % nct;
        if (!win_tile_needed(l, rt, ct)) continue;
        ngemm_tile(c, c.H(), nullptr, rt * 128, B, NIN, ct * 128, D, E);
    }
}
__device__ __forceinline__ void ph_gemm_out(const Ctx& c, int l) {
    const EpiX1 E{&c, l, c.XA()};
    const float* B = c.I(I_WOUT) + (size_t)l * D * D;
    const int rows = (l == 0) ? MT : TL, nct = D / 128, total = (rows / 128) * nct;
    for (int it = c.bid; it < total; it += c.nb) ngemm_tile(c, c.YM(), nullptr, (it / nct) * 128, B, D, (it % nct) * 128, D, E);
}

__device__ __forceinline__ void tile_rows(int tile, int& rowbase, int& L, int& t0) {
    if (tile < TL / 32) { const int b = tile / (SEQ / 32); rowbase = b * SEQ; L = SEQ; t0 = (tile % (SEQ / 32)) * 32; }
    else { const int tc = tile - TL / 32, b = tc / (CTXL / 32); rowbase = TL + b * CTXL; L = CTXL; t0 = (tc % (CTXL / 32)) * 32; }
}
__device__ __forceinline__ void conva_item(const Ctx& c, int l, int tile) {
    lfloat* zs = (lfloat*)c.lds;
    lfloat* red = (lfloat*)(c.lds + LDS_MISC);
    const int ch = c.tid; int rowbase, L, t0; tile_rows(tile, rowbase, L, t0);
    const bf16_t* U = c.U();
    { const bf16_t* up = U + ((long)rowbase + t0 - 15) * NIN + ch;
#pragma unroll 1
      for (int rr = 0; rr < 62; ++rr) { const int t = t0 - 15 + rr; float z = 0.f;
        if (t >= 0 && t < L) { const float val = bf2f(up[0]), gate = bf2f(up[512]); z = val * sigmoidf_(gate); }
        zs[rr * 512 + ch] = z; up += NIN; asm volatile("" : "+v"(up)); } }
    float w[31];
    { const float* wb = c.I(I_CAW) + (size_t)l * 31 * GW + ch; asm volatile("" : "+v"(wb));
#pragma unroll
      for (int k = 0; k < 31; ++k) w[k] = wb[k * GW]; }
    const float cb = c.I(I_CAB)[l * GW + ch];
#pragma unroll 1
    for (int r = 0; r < 32; ++r) { float acc = cb;
#pragma unroll
        for (int k = 0; k < 31; ++k) acc += w[k] * zs[(r + k) * 512 + ch];
        zs[r * 512 + ch] = acc; }
    const float g = c.I(I_LNAG)[l * GW + ch], bb = c.I(I_LNAB)[l * GW + ch];
#pragma unroll 1
    for (int hf = 0; hf < 2; ++hf) {
        float v[16], s[16];
#pragma unroll
        for (int r = 0; r < 16; ++r) { v[r] = zs[(hf * 16 + r) * 512 + ch]; s[r] = v[r]; }
        block_rowsum<16>(s, red, c.wave, c.lane);
#pragma unroll
        for (int r = 0; r < 16; ++r) { v[r] -= s[r] * (1.f / GW); s[r] = v[r] * v[r]; }
        block_rowsum<16>(s, red, c.wave, c.lane);
        bf16_t* yo = c.YM() + (size_t)(rowbase + t0 + hf * 16) * D + ch;
#pragma unroll
        for (int r = 0; r < 16; ++r) { const float y = v[r] * rsqrtf(s[r] * (1.f / GW) + EPS) * g + bb; *yo = (bf16_t)f2bf(y * sigmoidf_(y)); yo += D; asm volatile("" : "+v"(yo)); }
    }
}
__device__ __forceinline__ void convc_item(const Ctx& c, int l, int tile) {
    lfloat* red = (lfloat*)(c.lds + LDS_MISC);
    const int ch = c.tid; int rowbase, L, t0; tile_rows(tile, rowbase, L, t0);
    const bf16_t* U = c.U();
    const float w0 = c.I(I_CCW)[(l * 3 + 0) * GW + ch], w1 = c.I(I_CCW)[(l * 3 + 1) * GW + ch], w2 = c.I(I_CCW)[(l * 3 + 2) * GW + ch];
    float p[34];
#pragma unroll
    for (int rr = 0; rr < 34; ++rr) { const int t = t0 - 1 + rr; float z = 0.f;
        if (t >= 0 && t < L) { const bf16_t* up = U + (size_t)(rowbase + t) * NIN + 2560; z = bf2f(up[512 + ch]) * bf2f(up[1024 + ch]); }
        p[rr] = z; }
    float v[32], s[32];
#pragma unroll
    for (int r = 0; r < 32; ++r) { const float bg = bf2f(U[(size_t)(rowbase + t0 + r) * NIN + 2560 + ch]); v[r] = bg * (w0 * p[r] + w1 * p[r + 1] + w2 * p[r + 2]); s[r] = v[r] * v[r]; }
    block_rowsum<32>(s, red, c.wave, c.lane);
    const float g = c.I(I_NCG)[l * GW + ch];
    bf16_t* yo = c.YM() + (size_t)(rowbase + t0) * D + 1024 + ch;
#pragma unroll
    for (int r = 0; r < 32; ++r) { *yo = (bf16_t)f2bf(v[r] * rsqrtf(s[r] * (1.f / GW) + EPS) * g); yo += D; asm volatile("" : "+v"(yo)); }
}
__device__ __forceinline__ float gelu_tanh(float x) { return 0.5f * x * (1.f + tanhf(0.7978845608028654f * (x + 0.044715f * x * x * x))); }
__device__ __forceinline__ void lru_item(const Ctx& c, int l, int item, int mode) {
    lfloat* xs = (lfloat*)c.lds;
    lfloat* hs = xs + 32 * 512;
    lfloat* red = (lfloat*)(c.lds + LDS_MISC);
    float* SP = (float*)(c.ws + WS_SP);
    const int ch = c.tid, blk = ch >> 6, j = ch & 63;
    const int b = item / NCHUNK, cidx = item % NCHUNK; const bool is_ctx = cidx < 8;
    const int L = is_ctx ? CTXL : SEQ, t0 = (is_ctx ? cidx : cidx - 8) * 32, rowbase = is_ctx ? TL + b * CTXL : b * SEQ;
    const bf16_t* U = c.U();
    const bf16_t* recp = U + (size_t)rowbase * NIN + 4608 + ch;
    for (int d = 0; d < 2; ++d) {
        const int ld = l * 2 + d;
        const float cw0 = c.I(I_LCW)[(ld * 4 + 0) * GW + ch], cw1 = c.I(I_LCW)[(ld * 4 + 1) * GW + ch], cw2 = c.I(I_LCW)[(ld * 4 + 2) * GW + ch], cw3 = c.I(I_LCW)[(ld * 4 + 3) * GW + ch];
        const float cbv = c.I(I_LCB)[ld * GW + ch];
        for (int r = 0; r < 32; ++r) { const int tb = t0 + r - (d == 0 ? 3 : 0); float acc = cbv;
            { const int tt = tb + 0; if (tt >= 0 && tt < L) acc += cw0 * bf2f(recp[(size_t)tt * NIN]); }
            { const int tt = tb + 1; if (tt >= 0 && tt < L) acc += cw1 * bf2f(recp[(size_t)tt * NIN]); }
            { const int tt = tb + 2; if (tt >= 0 && tt < L) acc += cw2 * bf2f(recp[(size_t)tt * NIN]); }
            { const int tt = tb + 3; if (tt >= 0 && tt < L) acc += cw3 * bf2f(recp[(size_t)tt * NIN]); }
            xs[r * 512 + ch] = acc; }
        __syncthreads();
        float wa[64], wx[64];
        { const float* pa = c.I(I_LWA) + ((size_t)(ld * 8 + blk) * 64) * 64 + j; const float* px = c.I(I_LWX) + ((size_t)(ld * 8 + blk) * 64) * 64 + j;
#pragma unroll
          for (int i = 0; i < 64; ++i) { wa[i] = pa[i * 64]; wx[i] = px[i * 64]; } }
        const float bav = c.I(I_LBA)[ld * GW + ch], bxv = c.I(I_LBX)[ld * GW + ch];
        const float lamv = c.I(I_LLAM)[ld * GW + ch];
        const float sp = log1pf(__expf(-lamv));
        float h = 0.f;
        if (mode == 1) {
            const float* spb = SP + ((size_t)(d * NB + b) * NCHUNK) * 2 * GW + ch;
            if (d == 0) { for (int cc = 0; cc < cidx; ++cc) h = spb[(size_t)cc * 2 * GW] * h + spb[(size_t)cc * 2 * GW + GW]; }
            else {
                if (is_ctx) { for (int cc = 7; cc > cidx; --cc) h = spb[(size_t)cc * 2 * GW] * h + spb[(size_t)cc * 2 * GW + GW]; }
                else { for (int cc = 7; cc >= 0; --cc) h = spb[(size_t)cc * 2 * GW] * h + spb[(size_t)cc * 2 * GW + GW];
                       for (int cc = NCHUNK - 1; cc > cidx; --cc) h = spb[(size_t)cc * 2 * GW] * h + spb[(size_t)cc * 2 * GW + GW]; }
            }
        }
        float aprod = 1.f;
        for (int rr = 0; rr < 32; ++rr) {
            const int r = (d == 0) ? rr : 31 - rr;
            float ra = bav, ri = bxv;
            const lfloat* xr = xs + r * 512 + blk * 64;
#pragma unroll
            for (int i4 = 0; i4 < 16; ++i4) { const float4 xv = lds_ld4(xr + i4 * 4);
                ra += xv.x * wa[i4 * 4 + 0]; ri += xv.x * wx[i4 * 4 + 0]; ra += xv.y * wa[i4 * 4 + 1]; ri += xv.y * wx[i4 * 4 + 1];
                ra += xv.z * wa[i4 * 4 + 2]; ri += xv.z * wx[i4 * 4 + 2]; ra += xv.w * wa[i4 * 4 + 3]; ri += xv.w * wx[i4 * 4 + 3]; }
            const float rg = sigmoidf_(ra), ig = sigmoidf_(ri);
            const float la = -8.f * rg * sp, a = __expf(la);
            const float bb = sqrtf(fmaxf(-expm1f(2.f * la), 0.f)) * (ig * xs[r * 512 + ch]);
            h = a * h + bb; aprod *= a;
            if (mode == 1) {
                if (d == 0) hs[r * 512 + ch] = h;
                else { const float o = hs[r * 512 + ch] + h; const float gate = bf2f(U[(size_t)(rowbase + t0 + r) * NIN + 4096 + ch]); hs[r * 512 + ch] = gelu_tanh(gate) * o; }
            }
        }
        if (mode == 0) { float* spo = SP + ((size_t)((d * NB + b) * NCHUNK + cidx)) * 2 * GW + ch; spo[0] = aprod; spo[GW] = h; }
        __syncthreads();
    }
    if (mode == 1) {
        float v[32], s[32];
#pragma unroll
        for (int r = 0; r < 32; ++r) { v[r] = hs[r * 512 + ch]; s[r] = v[r] * v[r]; }
        block_rowsum<32>(s, red, c.wave, c.lane);
        const float g = c.I(I_NDG)[l * GW + ch];
        bf16_t* yo = c.YM() + (size_t)(rowbase + t0) * D + 1536 + ch;
#pragma unroll
        for (int r = 0; r < 32; ++r) { *yo = (bf16_t)f2bf(v[r] * rsqrtf(s[r] * (1.f / GW) + EPS) * g); yo += D; asm volatile("" : "+v"(yo)); }
    }
}

__device__ __forceinline__ void load_head_tile(lfloat* dst, const bf16_t* U, int row0, int cb, int pos0, float sc, int tid) {
    for (int it = tid; it < 64 * 32; it += 512) {
        const int i = it >> 5, p = it & 31, a = p >> 4, ii = p & 15, dA = a * 32 + ii, dB = dA + 16;
        const bf16_t* up = U + (size_t)(row0 + i) * NIN + cb;
        float xA = bf2f(up[dA]), xB = bf2f(up[dB]);
        if (pos0 >= 0) { const int pos = pos0 + i; const float pp = (a == 0) ? (float)(pos >> 6) : (float)(pos & 63);
            const float inv = exp2f(-(float)ii * (13.287712379549449f / 16.f));
            const float ang = pp * inv, cs = __cosf(ang), sn = __sinf(ang);
            const float yA = xA * cs - xB * sn, yB = xB * cs + xA * sn; xA = yA; xB = yB; }
        dst[i * 65 + dA] = xA * sc; dst[i * 65 + dB] = xB * sc;
    }
}
__device__ __forceinline__ float lam_init_of(int l) { return l == 0 ? 0.2f : 0.35550906759096927f; }
__device__ __forceinline__ void attn_item(const Ctx& c, int l, int item, bool ctxq) {
    lfloat* Qs = (lfloat*)c.lds; lfloat* Ks = Qs + 64 * 65; lfloat* Ps = Ks + 64 * 65; lfloat* Vs = Ps + 64 * 65;
    const int tid = c.tid, q = tid >> 3, sub = tid & 7;
    const int nqt = ctxq ? CTXL / 64 : SEQ / 64;
    const int b = item / (4 * nqt), dh = (item / nqt) % 4, qt = item % nqt;
    const int qrow0 = ctxq ? TL + b * CTXL + qt * 64 : b * SEQ + qt * 64;
    const int nkt = ctxq ? 4 : 36;
    const bf16_t* U = c.U();
    float lam; { const float* lv = c.I(I_DLAM) + l * 4 * 64; float s0 = 0.f, s1 = 0.f; for (int i = 0; i < 64; ++i) { s0 += lv[i] * lv[64 + i]; s1 += lv[128 + i] * lv[192 + i]; } lam = __expf(s0) - __expf(s1) + lam_init_of(l); }
    float o0[16];
#pragma unroll
    for (int d = 0; d < 16; ++d) o0[d] = 0.f;
    float res[16];
    for (int jm = 0; jm < 2; ++jm) {
        const int hq = 2 * dh + jm;
        __syncthreads();
        load_head_tile(Qs, U, qrow0, 1024 + hq * 64, ctxq ? -1 : qt * 64, 0.125f, tid);
        float m = -1e30f, lsum = 0.f, o[16];
#pragma unroll
        for (int d = 0; d < 16; ++d) o[d] = 0.f;
        for (int kt = 0; kt < nkt; ++kt) {
            const int krow0 = (kt < 4) ? TL + b * CTXL + kt * 64 : b * SEQ + (kt - 4) * 64;
            __syncthreads();
            load_head_tile(Ks, U, krow0, 1536 + hq * 64, (kt < 4) ? -1 : (kt - 4) * 64, 1.f, tid);
            for (int it = tid; it < 64 * 32; it += 512) { const int i = it >> 5, d4 = (it & 31) * 4; const uint2 vv = *(const uint2*)(U + (size_t)(krow0 + i) * NIN + 2048 + dh * 128 + d4);
                lfloat* vd = Vs + i * 128 + d4; vd[0] = __uint_as_float(vv.x << 16); vd[1] = __uint_as_float(vv.x & 0xffff0000u); vd[2] = __uint_as_float(vv.y << 16); vd[3] = __uint_as_float(vv.y & 0xffff0000u); }
            __syncthreads();
            float s[8]; float tmax = -1e30f;
#pragma unroll
            for (int i8 = 0; i8 < 8; ++i8) { const int key = sub + 8 * i8; float a = 0.f;
                for (int d = 0; d < 64; ++d) a += Qs[q * 65 + d] * Ks[key * 65 + d];
                s[i8] = a; tmax = fmaxf(tmax, a); }
            tmax = fmaxf(tmax, __shfl_xor(tmax, 1)); tmax = fmaxf(tmax, __shfl_xor(tmax, 2)); tmax = fmaxf(tmax, __shfl_xor(tmax, 4));
            const float mnew = fmaxf(m, tmax), alpha = __expf(m - mnew);
            float psum = 0.f;
#pragma unroll
            for (int i8 = 0; i8 < 8; ++i8) { const float pe = __expf(s[i8] - mnew); psum += pe; Ps[q * 65 + sub + 8 * i8] = pe; }
            psum += __shfl_xor(psum, 1); psum += __shfl_xor(psum, 2); psum += __shfl_xor(psum, 4);
            lsum = lsum * alpha + psum; m = mnew;
#pragma unroll
            for (int d = 0; d < 16; ++d) o[d] *= alpha;
            __syncthreads();
            for (int key = 0; key < 64; ++key) { const float pv = Ps[q * 65 + key]; const lfloat* vr = Vs + key * 128 + sub * 16;
#pragma unroll
                for (int d4 = 0; d4 < 4; ++d4) { const float4 vv = lds_ld4(vr + d4 * 4); o[d4 * 4 + 0] += pv * vv.x; o[d4 * 4 + 1] += pv * vv.y; o[d4 * 4 + 2] += pv * vv.z; o[d4 * 4 + 3] += pv * vv.w; } }
        }
        const float il = 1.f / lsum;
        if (jm == 0) {
#pragma unroll
            for (int d = 0; d < 16; ++d) o0[d] = o[d] * il;
        } else {
#pragma unroll
            for (int d = 0; d < 16; ++d) res[d] = o0[d] - lam * (o[d] * il);
        }
    }
    float ss = 0.f;
#pragma unroll
    for (int d = 0; d < 16; ++d) ss += res[d] * res[d];
    ss += __shfl_xor(ss, 1); ss += __shfl_xor(ss, 2); ss += __shfl_xor(ss, 4);
    const float rstd = rsqrtf(ss * (1.f / 128.f) + EPS) * (1.f - lam_init_of(l));
    const float* g = c.I(I_DNG) + l * 128 + sub * 16;
    bf16_t* yo = c.YM() + (size_t)(qrow0 + q) * D + 512 + dh * 128 + sub * 16;
#pragma unroll
    for (int d = 0; d < 16; d += 2) *(unsigned*)(yo + d) = pk2(res[d] * rstd * g[d], res[d + 1] * rstd * g[d + 1]);
}

__device__ __forceinline__ void ph_norm2_router(const Ctx& c, int l) {
    const int rows = (l == 0) ? MT : TL;
    const float* g = c.I(I_N2G) + l * D;
    const float* X1 = c.XA();
    int* topi = (int*)(c.ws + WS_TOPI); float* gate = (float*)(c.ws + WS_GATE);
    unsigned* cnt = c.ctl() + CW_CNT + l * 32;
    lfloat* hrow = (lfloat*)c.lds;
    lfloat* part = hrow + 8 * 2048;
    lfloat* logit = part + 16 * 8 * 32;
    for (int r0 = c.bid * 8; r0 < rows; r0 += c.nb * 8) {
        const int r = r0 + c.wave;
        {
            const float4* src = (const float4*)(X1 + (size_t)r * D);
            float4 v[8]; float ss = 0.f;
#pragma unroll
            for (int j = 0; j < 8; ++j) { v[j] = src[j * 64 + c.lane]; ss += v[j].x * v[j].x + v[j].y * v[j].y + v[j].z * v[j].z + v[j].w * v[j].w; }
            const float rstd = rsqrtf(wave_sum(ss) * (1.f / D) + EPS);
            const float* m = c.mod() + (size_t)(l * 9 + mod_row(r)) * MODW;
            bf16_t* o = c.H() + (size_t)r * D;
#pragma unroll
            for (int j = 0; j < 8; ++j) {
                const int col = (j * 64 + c.lane) * 4;
                const float4 gg = *(const float4*)(g + col), sc = *(const float4*)(m + 4 * D + col), sh = *(const float4*)(m + 3 * D + col);
                const float h0 = v[j].x * rstd * gg.x * (1.f + sc.x) + sh.x, h1 = v[j].y * rstd * gg.y * (1.f + sc.y) + sh.y;
                const float h2 = v[j].z * rstd * gg.z * (1.f + sc.z) + sh.z, h3 = v[j].w * rstd * gg.w * (1.f + sc.w) + sh.w;
                *(uint2*)(o + col) = make_uint2(pk2(h0, h1), pk2(h2, h3));
                lds_st4(hrow + c.wave * 2048 + col, make_float4(h0, h1, h2, h3));
            }
        }
        __syncthreads();
        {
            const int e = c.lane & 31, hlf = c.lane >> 5, kb = c.wave * 256 + hlf * 128;
            const float* rwp = c.I(I_RW) + ((size_t)l * D + kb) * NE + e;
            float acc[8];
#pragma unroll
            for (int rr = 0; rr < 8; ++rr) acc[rr] = 0.f;
#pragma unroll 4
            for (int k = 0; k < 128; ++k) { const float w = rwp[k * NE];
#pragma unroll
                for (int rr = 0; rr < 8; ++rr) acc[rr] += hrow[rr * 2048 + kb + k] * w; }
#pragma unroll
            for (int rr = 0; rr < 8; ++rr) part[((c.wave * 2 + hlf) * 8 + rr) * 32 + e] = acc[rr];
        }
        __syncthreads();
        if (c.tid < 256) { const int rr = c.tid >> 5, ee = c.tid & 31; float s = c.I(I_RB)[l * NE + ee];
#pragma unroll
            for (int pp = 0; pp < 16; ++pp) s += part[(pp * 8 + rr) * 32 + ee];
            logit[rr * 32 + ee] = s; }
        __syncthreads();
        float mine = (c.lane < 32) ? logit[c.wave * 32 + c.lane] : -3e38f;
        float tv[4]; int ti[4];
#pragma unroll
        for (int k = 0; k < 4; ++k) { const float mx = wave_max(mine); const unsigned long long bal = __ballot(mine == mx); const int idx = __ffsll((long long)bal) - 1; tv[k] = mx; ti[k] = idx; if (c.lane == idx) mine = -3e38f; }
        const float e0 = 1.f, e1 = __expf(tv[1] - tv[0]), e2 = __expf(tv[2] - tv[0]), e3 = __expf(tv[3] - tv[0]);
        const float inv = 1.f / (e0 + e1 + e2 + e3);
        if (c.lane == 0) { *(int4*)(topi + (size_t)r * 4) = make_int4(ti[0], ti[1], ti[2], ti[3]); *(float4*)(gate + (size_t)r * 4) = make_float4(e0 * inv, e1 * inv, e2 * inv, e3 * inv); }
        if (c.lane < 4) { const int e = c.lane == 0 ? ti[0] : c.lane == 1 ? ti[1] : c.lane == 2 ? ti[2] : ti[3]; atomicAdd(cnt + e, 1u); }
    }
}
__device__ __forceinline__ void moe_tables(const Ctx& c, int l, lint* tab) {
    const unsigned* cnt = c.ctl() + CW_CNT + l * 32;
    __syncthreads();
    if (c.tid == 0) { int so = 0, to = 0; for (int e = 0; e < 32; ++e) { const int n = (int)__hip_atomic_load(cnt + e, __ATOMIC_RELAXED, __HIP_MEMORY_SCOPE_AGENT); tab[e] = n; tab[32 + e] = so; tab[64 + e] = to; const int nt = (n + 255) >> 8; so += nt * 256; to += nt; } tab[96] = to; }
    __syncthreads();
}
__device__ __forceinline__ void ph_slots(const Ctx& c, int l) {
    lint* tab = (lint*)(c.lds + LDS_MISC);
    moe_tables(c, l, tab);
    const int rows = (l == 0) ? MT : TL;
    const int* topi = (const int*)(c.ws + WS_TOPI); int* tslot = (int*)(c.ws + WS_TSLOT); int* stok = (int*)(c.ws + WS_STOK);
    unsigned* fill = c.ctl() + CW_FILL + l * 32;
    for (int i = c.bid * 512 + c.tid; i < rows * 4; i += c.nb * 512) { const int e = topi[i]; const int pos = (int)atomicAdd(fill + e, 1u); const int slot = tab[32 + e] + pos; tslot[i] = slot; stok[slot] = i >> 2; }
    if (c.bid == 0) for (int e = 0; e < 32; ++e) { const int n = tab[e], s0 = tab[32 + e], np = ((n + 255) >> 8) << 8; for (int s = n + c.tid; s < np; s += 512) stok[s0 + s] = 0; }
}
__device__ __forceinline__ int tile_expert(const lint* tab, int tile) { int e = 0; for (int k = 1; k < 32; ++k) if (tab[64 + k] <= tile) e = k; return e; }
__device__ __forceinline__ void ph_moe1(const Ctx& c, int l) {
    lint* tab = (lint*)(c.lds + LDS_MISC);
    moe_tables(c, l, tab);
    const int total = tab[96] * 32;
    const int* stok = (const int*)(c.ws + WS_STOK);
    for (int it = c.bid; it < total; it += c.nb) {
        const int tile = it >> 5, sub = it & 31, rh = sub >> 4, ct = sub & 15, e = tile_expert(tab, tile);
        const EpiAct E{c.I(I_B1) + (size_t)(l * NE + e) * D, (bf16_t*)(c.ws + WS_ACT)};
        ngemm_tile(c, c.H(), stok, tile * 256 + rh * 128, c.I(I_W1) + (size_t)(l * NE + e) * D * D, D, ct * 128, D, E);
    }
}
__device__ __forceinline__ void ph_moe2(const Ctx& c, int l) {
    lint* tab = (lint*)(c.lds + LDS_MISC);
    moe_tables(c, l, tab);
    const int total = tab[96] * 32;
    for (int it = c.bid; it < total; it += c.nb) {
        const int tile = it >> 5, sub = it & 31, rh = sub >> 4, ct = sub & 15, e = tile_expert(tab, tile);
        const EpiOS E{c.I(I_B2) + (size_t)(l * NE + e) * D, (bf16_t*)(c.ws + WS_OS)};
        ngemm_tile(c, (const bf16_t*)(c.ws + WS_ACT), nullptr, tile * 256 + rh * 128, c.I(I_W2) + (size_t)(l * NE + e) * DFF * D, D, ct * 128, DFF, E);
    }
}
__device__ __forceinline__ void ph_combine(const Ctx& c, int l) {
    const int rows = (l == 0) ? MT : TL;
    const float* X1 = c.XA(); const bf16_t* OS = (const bf16_t*)(c.ws + WS_OS);
    const int* tslot = (const int*)(c.ws + WS_TSLOT); const float* gate = (const float*)(c.ws + WS_GATE);
    for (int r = c.bid * 8 + c.wave; r < rows; r += c.nb * 8) {
        const int4 sl = *(const int4*)(tslot + (size_t)r * 4); const float4 gt = *(const float4*)(gate + (size_t)r * 4);
        const float* m = c.mod() + (size_t)(l * 9 + mod_row(r)) * MODW + 5 * D;
        const bf16_t* o0 = OS + (size_t)sl.x * D; const bf16_t* o1 = OS + (size_t)sl.y * D; const bf16_t* o2 = OS + (size_t)sl.z * D; const bf16_t* o3 = OS + (size_t)sl.w * D;
        float4 v[8]; float ss = 0.f;
#pragma unroll
        for (int j = 0; j < 8; ++j) {
            const int col = (j * 64 + c.lane) * 4;
            const float4 x1 = *(const float4*)(X1 + (size_t)r * D + col), g2 = *(const float4*)(m + col);
            const uint2 a = *(const uint2*)(o0 + col), b = *(const uint2*)(o1 + col), cc = *(const uint2*)(o2 + col), d = *(const uint2*)(o3 + col);
            const float f0 = gt.x * __uint_as_float(a.x << 16) + gt.y * __uint_as_float(b.x << 16) + gt.z * __uint_as_float(cc.x << 16) + gt.w * __uint_as_float(d.x << 16);
            const float f1 = gt.x * __uint_as_float(a.x & 0xffff0000u) + gt.y * __uint_as_float(b.x & 0xffff0000u) + gt.z * __uint_as_float(cc.x & 0xffff0000u) + gt.w * __uint_as_float(d.x & 0xffff0000u);
            const float f2 = gt.x * __uint_as_float(a.y << 16) + gt.y * __uint_as_float(b.y << 16) + gt.z * __uint_as_float(cc.y << 16) + gt.w * __uint_as_float(d.y << 16);
            const float f3 = gt.x * __uint_as_float(a.y & 0xffff0000u) + gt.y * __uint_as_float(b.y & 0xffff0000u) + gt.z * __uint_as_float(cc.y & 0xffff0000u) + gt.w * __uint_as_float(d.y & 0xffff0000u);
            v[j] = make_float4(x1.x + g2.x * f0, x1.y + g2.y * f1, x1.z + g2.z * f2, x1.w + g2.w * f3);
            ss += v[j].x * v[j].x + v[j].y * v[j].y + v[j].z * v[j].z + v[j].w * v[j].w;
        }
        if (l == 0) {
#pragma unroll
            for (int j = 0; j < 8; ++j) *(float4*)(c.XB() + (size_t)r * D + (j * 64 + c.lane) * 4) = v[j];
        } else {
            const float rstd = rsqrtf(wave_sum(ss) * (1.f / D) + EPS);
#pragma unroll
            for (int j = 0; j < 8; ++j) { const int col = (j * 64 + c.lane) * 4; const float4 fg = *(const float4*)(c.I(I_FG) + col);
                *(float4*)(c.out + (size_t)r * D + col) = make_float4(v[j].x * rstd * fg.x, v[j].y * rstd * fg.y, v[j].z * rstd * fg.z, v[j].w * rstd * fg.w); }
        }
    }
}

constexpr int PH_PER_LAYER = 10, N_PHASES = 2 + 2 * PH_PER_LAYER;
template <int K> __global__ void __launch_bounds__(512, 2) mk_ph(Params p) {
    extern __shared__ __attribute__((aligned(16))) unsigned char lds[];
    Ctx c; c.in = p.in; c.out = p.out; c.ws = p.ws; c.tid = threadIdx.x; c.lane = c.tid & 63; c.wave = __builtin_amdgcn_readfirstlane(c.tid >> 6); c.bid = blockIdx.x; c.nb = gridDim.x; c.lds = (LAS unsigned char*)lds;
    const int l = p.ph_lo;
    if constexpr (K == 0) ph_mod_partial(c);
    if constexpr (K == 1) ph_mod_reduce(c);
    if constexpr (K == 2) ph_norm1(c, l);
    if constexpr (K == 3) ph_gemm_in(c, l);
    if constexpr (K == 4) {
        const int nA = (l == 0) ? MT / 32 : TL / 32;
        for (int it = c.bid; it < nA; it += c.nb) conva_item(c, l, it);
        for (int it = c.bid; it < nA; it += c.nb) convc_item(c, l, it);
        for (int it = c.bid; it < NB * NCHUNK; it += c.nb) lru_item(c, l, it, 0);
    }
    if constexpr (K == 5) {
        for (int it = c.bid; it < NB * 4 * (SEQ / 64); it += c.nb) attn_item(c, l, it, false);
        if (l == 0) for (int it = c.bid; it < NB * 4 * (CTXL / 64); it += c.nb) attn_item(c, l, it, true);
        for (int it = c.bid; it < NB * NCHUNK; it += c.nb) { if (l == 1 && (it % NCHUNK) < 8) continue; lru_item(c, l, it, 1); }
    }
    if constexpr (K == 6) ph_gemm_out(c, l);
    if constexpr (K == 7) ph_norm2_router(c, l);
    if constexpr (K == 8) ph_slots(c, l);
    if constexpr (K == 9) ph_moe1(c, l);
    if constexpr (K == 10) ph_moe2(c, l);
    if constexpr (K == 11) ph_combine(c, l);
}
template <int K> static void launch_ph(int grid, Params& p, int l, hipStream_t stream) {
    static bool attr = false;
    if (!attr) { (void)hipFuncSetAttribute((const void*)mk_ph<K>, hipFuncAttributeMaxDynamicSharedMemorySize, LDS_BYTES); attr = true; }
    p.ph_lo = l; p.ph_hi = l + 1;
    hipLaunchKernelGGL(mk_ph<K>, dim3(grid), dim3(512), LDS_BYTES, stream, p);
}

extern "C" void kernel_launch(void* const* d_in, const int* in_sizes, int n_in, void* d_out, int out_size, void* d_ws, size_t ws_size, hipStream_t stream) {
    static int grid = 0;
    if (grid == 0) {
        if (n_in != N_INPUTS || out_size != TL * D || ws_size < WS_END) { fprintf(stderr, "kernel_launch: unexpected shapes (n_in %d, out %d, ws %zu)\n", n_in, out_size, ws_size); grid = -1; return; }
        int dev = 0, cus = 0;
        if (hipGetDevice(&dev) != hipSuccess || hipDeviceGetAttribute(&cus, hipDeviceAttributeMultiprocessorCount, dev) != hipSuccess) { grid = -1; return; }
        grid = cus;
    }
    if (grid < 0) return;
    (void)hipMemsetAsync((char*)d_ws + WS_CTL, 0, CTL_BYTES, stream);
    Params p{};
    for (int i = 0; i < N_INPUTS; ++i) p.in[i] = (const float*)d_in[i];
    p.out = (float*)d_out; p.ws = (unsigned char*)d_ws;
    launch_ph<0>(grid, p, 0, stream); launch_ph<1>(grid, p, 0, stream);
    for (int l = 0; l < 2; ++l) {
        launch_ph<2>(grid, p, l, stream); launch_ph<3>(grid, p, l, stream); launch_ph<4>(grid, p, l, stream); launch_ph<5>(grid, p, l, stream); launch_ph<6>(grid, p, l, stream);
        launch_ph<7>(grid, p, l, stream); launch_ph<8>(grid, p, l, stream); launch_ph<9>(grid, p, l, stream); launch_ph<10>(grid, p, l, stream); launch_ph<11>(grid, p, l, stream);
    }
}
```

```cpp
#include <hip/hip_runtime.h>
#include <cstdio>

typedef unsigned short bf16_t;
#define LAS __attribute__((address_space(3)))
typedef LAS float lfloat;
typedef float f32x4 __attribute__((ext_vector_type(4)));
typedef LAS f32x4 lf32x4;
__device__ __forceinline__ float4 lds_ld4(const lfloat* p) { const f32x4 v = *(const lf32x4*)p; return make_float4(v.x, v.y, v.z, v.w); }
__device__ __forceinline__ void lds_st4(lfloat* p, float4 v) { *(lf32x4*)p = (f32x4){v.x, v.y, v.z, v.w}; }
typedef LAS int lint;

constexpr int D = 2048, NB = 8, SEQ = 2048, CTXL = 256;
constexpr int TL = NB * SEQ;
constexpr int TC = NB * CTXL;
constexpr int MT = TL + TC;
constexpr int NIN = 5120, GW = 512, NE = 32, DFF = 1024;
constexpr int MODW = 6 * D;
constexpr int NSLOT = 81920;
constexpr float EPS = 1e-6f;
constexpr int NKC = 16;
constexpr int NCHUNK = 36, NCC = 4;

enum { I_X = 0, I_C, I_CTX, I_CCTX, I_ADAW, I_ADAB, I_N1G, I_N2G, I_WIN, I_WOUT, I_CAW, I_CAB, I_LNAG, I_LNAB, I_DLAM, I_DNG, I_CCW, I_NCG,
       I_LCW, I_LCB, I_LWA, I_LBA, I_LWX, I_LBX, I_LLAM, I_NDG, I_RW, I_RB, I_W1, I_B1, I_W2, I_B2, I_FG, N_INPUTS };

constexpr size_t MiB = 1ull << 20;
constexpr size_t WS_CTL = 0, CTL_BYTES = 1 * MiB;
constexpr size_t WS_MODP = 1 * MiB;
constexpr size_t WS_MOD = 17 * MiB;
constexpr size_t WS_H = 18 * MiB;
constexpr size_t WS_U = 90 * MiB;
constexpr size_t WS_YM = 270 * MiB;
constexpr size_t WS_XA = 342 * MiB;
constexpr size_t WS_XB = 486 * MiB;
constexpr size_t WS_SP = 630 * MiB;
constexpr size_t WS_TOPI = 636 * MiB;
constexpr size_t WS_GATE = 637 * MiB;
constexpr size_t WS_TSLOT = 638 * MiB;
constexpr size_t WS_STOK = 639 * MiB;
constexpr size_t WS_ACT = 640 * MiB;
constexpr size_t WS_OS = 800 * MiB;
constexpr size_t WS_WIN = 1120 * MiB;
constexpr size_t WS_WOUT = 1160 * MiB;
constexpr size_t WS_W1T = 1176 * MiB;
constexpr size_t WS_W2T = 1688 * MiB;
constexpr size_t WS_OST = 1944 * MiB;
constexpr size_t WS_RWF = 2013 * MiB;
constexpr size_t WS_H8 = 1977 * MiB;
constexpr size_t WS_WG = 1976 * MiB;
constexpr size_t WS_END = 2014 * MiB;
constexpr int CW_CNT = 16384;
constexpr int CW_TS = 65536;
constexpr int CW_FILL = 16384 + 4096;
constexpr int CW_BAR = 4096;

constexpr int LDS_BYTES = 147456;
constexpr int LDS_MISC = 131072;
constexpr int LDS_IDX = LDS_MISC + 8192;
constexpr int LDS_XB = LDS_BYTES - 16;

struct Params { const float* in[N_INPUTS]; float* out; unsigned char* ws; int ph_lo, ph_hi, li, pad; };

__device__ __forceinline__ float bf2f(bf16_t h) { return __uint_as_float(((unsigned)h) << 16); }
__device__ __forceinline__ unsigned f2bf(float f) { unsigned u = __float_as_uint(f); return (u + 0x7fffu + ((u >> 16) & 1u)) >> 16; }
__device__ __forceinline__ unsigned pk2(float lo, float hi) { return f2bf(lo) | (f2bf(hi) << 16); }
__device__ __forceinline__ unsigned pk4_fp8(float a, float b, float c2, float d) {
    a = fminf(fmaxf(a, -448.f), 448.f); b = fminf(fmaxf(b, -448.f), 448.f); c2 = fminf(fmaxf(c2, -448.f), 448.f); d = fminf(fmaxf(d, -448.f), 448.f);
    int w = 0; w = __builtin_amdgcn_cvt_pk_fp8_f32(a, b, w, false); w = __builtin_amdgcn_cvt_pk_fp8_f32(c2, d, w, true); return (unsigned)w;
}
constexpr float W8S = 32.f;
__device__ __forceinline__ float sigmoidf_(float x) { return __builtin_amdgcn_rcpf(1.f + __expf(-x)); }
__device__ __forceinline__ float wave_sum(float v) {
#pragma unroll
    for (int o = 1; o < 64; o <<= 1) v += __shfl_xor(v, o);
    return v;
}
__device__ __forceinline__ float wave_max(float v) {
#pragma unroll
    for (int o = 1; o < 64; o <<= 1) v = fmaxf(v, __shfl_xor(v, o));
    return v;
}
template <int R> __device__ __forceinline__ void block_rowsum(float (&v)[R], lfloat* red, int wave, int lane) {
#pragma unroll
    for (int r = 0; r < R; ++r) { const float s = wave_sum(v[r]); if (lane == 0) red[wave * R + r] = s; }
    __syncthreads();
#pragma unroll
    for (int r = 0; r < R; ++r) { float s = 0.f;
#pragma unroll
        for (int w = 0; w < 8; ++w) s += red[w * R + r];
        v[r] = s; }
    __syncthreads();
}


#define XB_TMO      128
#define XB_XCNT(j)  (256  + 64 * (j))
#define XB_XSUB(j)  (1280 + 64 * (j))
#define XB_XGEN(j)  (2304 + 64 * (j))
#define XB_TOP      3328
#define XB_TOPGEN   3392
#define XCD_BAR_WORDS 3456
#define XB_SPIN_CAP (1u << 18)
__device__ __forceinline__ unsigned xb_ld(unsigned* p)              { return __hip_atomic_load(p, __ATOMIC_RELAXED, __HIP_MEMORY_SCOPE_AGENT); }
__device__ __forceinline__ unsigned xb_add(unsigned* p, unsigned v) { return __hip_atomic_fetch_add(p, v, __ATOMIC_RELAXED, __HIP_MEMORY_SCOPE_AGENT); }
__device__ __forceinline__ unsigned xb_xcc_id() { return (unsigned)__builtin_amdgcn_s_getreg((3 << 11) | 20) & 0xFu; }
#define XB_SPIN(cond, bar) do { unsigned _sp = 0; while (cond) { __builtin_amdgcn_s_sleep(1); \
    if ((++_sp & 255u) == 0u) { if (xb_ld(&(bar)[XB_TMO])) break; if (_sp > XB_SPIN_CAP) { atomicAdd(&(bar)[XB_TMO], 1u); break; } } } } while (0)
struct XcdBarrier { unsigned* bar; unsigned x; volatile LAS unsigned* st; };
__device__ __forceinline__ XcdBarrier xcd_barrier_post(unsigned* bar, volatile LAS unsigned* st) {
    XcdBarrier b; b.bar = bar; b.x = xb_xcc_id(); b.st = st;
    if (threadIdx.x == 0) (void)xb_add(&bar[XB_XCNT(b.x)], 1u);
    return b;
}
__device__ __forceinline__ void xcd_barrier_complete(unsigned* bar, unsigned x, unsigned& nloc, unsigned& nx) {
    const unsigned G = gridDim.x * gridDim.y * gridDim.z;
    unsigned sum, cnt, mine, sp = 0u;
    for (;;) {
        sum = 0u; cnt = 0u; mine = 0u;
#pragma unroll
        for (unsigned j = 0; j < 16; ++j) { const unsigned c = xb_ld(&bar[XB_XCNT(j)]); sum += c; cnt += (c > 0u) ? 1u : 0u; mine = (j == x) ? c : mine; }
        if (sum == G) break;
        __builtin_amdgcn_s_sleep(1);
        if ((++sp & 255u) == 0u) { if (xb_ld(&bar[XB_TMO])) break; if (sp > XB_SPIN_CAP) { atomicAdd(&bar[XB_TMO], 1u); break; } }
    }
    nloc = mine > 0u ? mine : 1u; nx = cnt > 0u ? cnt : 1u;
}
template <bool FIRST> __device__ __forceinline__ void xcd_barrier(const XcdBarrier& b, int wave_id) {
    asm volatile("s_waitcnt vmcnt(0)" ::: "memory");
    __syncthreads();
    if (wave_id == 0 && __builtin_amdgcn_mbcnt_hi(~0u, __builtin_amdgcn_mbcnt_lo(~0u, 0u)) == 0u) {
        unsigned* bar = b.bar;
        __builtin_amdgcn_s_waitcnt(0);
        unsigned nloc = b.st[0], nx = b.st[1];
        if constexpr (FIRST) { if (nloc == 0u) { xcd_barrier_complete(bar, b.x, nloc, nx); b.st[0] = nloc; b.st[1] = nx; } }
        const unsigned old = xb_add(&bar[XB_XSUB(b.x)], 1u);
        const unsigned gen = old / nloc;
        if (old + 1u == (gen + 1u) * nloc) {
            __builtin_amdgcn_fence(__ATOMIC_RELEASE, "agent");
            asm volatile("s_waitcnt vmcnt(0)" ::: "memory");
            const unsigned og = xb_add(&bar[XB_TOP], 1u);
            const unsigned tg = og / nx;
            if (og + 1u == (tg + 1u) * nx) xb_add(&bar[XB_TOPGEN], 1u);
            else XB_SPIN(xb_ld(&bar[XB_TOPGEN]) == tg, bar);
            __builtin_amdgcn_fence(__ATOMIC_ACQUIRE, "agent");
            xb_add(&bar[XB_XGEN(b.x)], 1u);
            asm volatile("s_waitcnt vmcnt(0)" ::: "memory");
        } else {
            XB_SPIN(xb_ld(&bar[XB_XGEN(b.x)]) == gen, bar);
            __builtin_amdgcn_fence(__ATOMIC_ACQUIRE, "agent");
            asm volatile("s_waitcnt vmcnt(0)" ::: "memory");
        }
    }
    __syncthreads();
}

struct Ctx {
    const float* const* in; float* out; unsigned char* ws;
    int tid, lane, wave, bid, nb, flag;
    LAS unsigned char* lds;
    __device__ __forceinline__ const float* I(int i) const { asm volatile("" : "+s"(i)); return in[i]; }
    __device__ __forceinline__ float* mod() const { return (float*)(ws + WS_MOD); }
    __device__ __forceinline__ bf16_t* H() const { return (bf16_t*)(ws + WS_H); }
    __device__ __forceinline__ bf16_t* U() const { return (bf16_t*)(ws + WS_U); }
    __device__ __forceinline__ bf16_t* YM() const { return (bf16_t*)(ws + WS_YM); }
    __device__ __forceinline__ bf16_t* XA() const { return (bf16_t*)(ws + WS_XA); }
    __device__ __forceinline__ bf16_t* XB() const { return (bf16_t*)(ws + WS_XB); }
    __device__ __forceinline__ unsigned* ctl() const { return (unsigned*)(ws + WS_CTL); }
};


namespace pg8 {
typedef short bf16x8 __attribute__((ext_vector_type(8)));
typedef float f32x4 __attribute__((ext_vector_type(4)));
typedef unsigned u32x4 __attribute__((ext_vector_type(4)));
typedef unsigned u32x2 __attribute__((ext_vector_type(2)));
constexpr int BM = 256, BK = 64, HALF = 128, HTB = HALF * BK * 2, STAGE_BYTES = 8 * HTB;
__device__ __forceinline__ int lds_byte(int r, int c) { const int st = (r >> 4) * 2 + (c >> 5), rr = r & 15, cc = c & 31, ob = rr * 64 + cc * 2; return st * 1024 + (ob ^ (((ob >> 9) & 1) << 5)); }
__device__ __forceinline__ void stage_rc(int b, int& R, int& C) { const int st = b / 1024, sb = b % 1024, swz = sb ^ (((sb >> 9) & 1) << 5); R = (st >> 1) * 16 + swz / 64; C = (st & 1) * 32 + (swz % 64) / 2; }
__device__ __forceinline__ int perm32(int rho) { const int n = rho >> 4, i = rho & 15; return 8 * (i >> 2) + 4 * n + (i & 3); }
__device__ __forceinline__ unsigned cvt_pk_bf16(float lo, float hi) { unsigned r; asm volatile("v_cvt_pk_bf16_f32 %0, %1, %2" : "=v"(r) : "v"(lo), "v"(hi)); return r; }
__device__ __forceinline__ int fresh_lane() { unsigned z = 0u; asm volatile("" : "+v"(z)); return (int)__builtin_amdgcn_mbcnt_hi(~0u, __builtin_amdgcn_mbcnt_lo(~0u, z)); }
struct Unit { int row0, col0, e; };
__device__ __forceinline__ void tile_order(int L, int nM, int nN, int& pm, int& pn) {
    const int nwg = nM * nN; int wgid = L; { const int q = nwg / 8, r = nwg % 8, xcd = wgid % 8, off = wgid / 8; wgid = (xcd < r ? xcd * (q + 1) : r * (q + 1) + (xcd - r) * q) + off; }
    const int nig = 8 * nN, gid = wgid / nig, fm = gid * 8, gsz = (nM - fm) < 8 ? (nM - fm) : 8;
    pm = fm + ((wgid % nig) % gsz); pn = (wgid % nig) / gsz;
}
template <int KB  , bool GATHER, bool FP8  , class Epi, class Sched>
__device__ __forceinline__ void gemm_phase(LAS unsigned char* lds, LAS unsigned char* idxslot, const Sched& S, const Epi& E, int tid) {
    const int wid = __builtin_amdgcn_readfirstlane(tid >> 6), lane = tid & 63, wr = wid >> 2, wc = wid & 3, fr = lane & 15, fq = lane >> 4;
    constexpr int nt = KB / 128;
    static_assert(nt >= 4 && nt % 2 == 0, "K-tile count");
    typedef int i32x4 __attribute__((ext_vector_type(4)));
    typedef int i32x8 __attribute__((ext_vector_type(8)));
    unsigned vo[2][2], voffB[2];
#pragma unroll
    for (int i = 0; i < 2; ++i) { int R, C; stage_rc(tid * 16 + i * 8192, R, C); const int Rb = Epi::PERM ? ((R & ~31) + perm32(R & 31)) : R;
        vo[0][i] = (unsigned)(R * KB + C * 2); vo[1][i] = (unsigned)((R + HALF) * KB + C * 2); voffB[i] = (unsigned)(Rb * KB + C * 2); }
    constexpr size_t kstep = 128, hstep = (size_t)HALF * KB;
    const unsigned ldsb = (unsigned)__builtin_amdgcn_readfirstlane((int)(unsigned)(size_t)lds + wid * 1024);
    const int aoff = lds_byte(wr * 64 + fr, fq * 8), boff = lds_byte(wc * 32 + fr, fq * 8);
#define PG8_SA(b, h) (((b) * 2 + (h)) * HTB)
#define PG8_SB(b, h) ((4 + (b) * 2 + (h)) * HTB)
#define PG8_GLDS(sbase, voff32, ldsdst) do { unsigned _keep; asm volatile("s_mov_b32 %0, m0\n\ts_mov_b32 m0, %3\n\ts_nop 0\n\tglobal_load_lds_dwordx4 %1, %2\n\ts_mov_b32 m0, %0" \
        : "=&s"(_keep) : "v"(voff32), "s"(sbase), "s"(ldsdst) : "memory"); } while (0)
#define PG8_STAGEB(bufoff, gbase) do { _Pragma("unroll") for (int _i = 0; _i < 2; ++_i) PG8_GLDS((const char*)(gbase), voffB[_i], ldsb + (unsigned)((bufoff) + _i * 8192)); } while (0)
#define PG8_STAGEA(bufoff, gbase, V, h) do { _Pragma("unroll") for (int _i = 0; _i < 2; ++_i) PG8_GLDS((const char*)(gbase) + (GATHER ? 0 : (h) * hstep), (V)[GATHER ? (h) : 0][_i], ldsb + (unsigned)((bufoff) + _i * 8192)); } while (0)
#define PG8_LDA(dst, b, h) do { _Pragma("unroll") for (int m = 0; m < 4; ++m) { const i32x4 _lo = *(const LAS i32x4*)(lds + PG8_SA(b, h) + aoff + m * 2048), _hi = *(const LAS i32x4*)(lds + PG8_SA(b, h) + aoff + m * 2048 + 1024); \
        dst[m] = __builtin_shufflevector(_lo, _hi, 0, 1, 2, 3, 4, 5, 6, 7); } } while (0)
#define PG8_LDB(dst, b, h) do { _Pragma("unroll") for (int n = 0; n < 2; ++n) { const i32x4 _lo = *(const LAS i32x4*)(lds + PG8_SB(b, h) + boff + n * 2048), _hi = *(const LAS i32x4*)(lds + PG8_SB(b, h) + boff + n * 2048 + 1024); \
        dst[n] = __builtin_shufflevector(_lo, _hi, 0, 1, 2, 3, 4, 5, 6, 7); } } while (0)
#define PG8_MMA(ai, bj, At, Bt) do { __builtin_amdgcn_s_setprio(1); _Pragma("unroll") for (int m = 0; m < 4; ++m) _Pragma("unroll") for (int n = 0; n < 2; ++n) { \
        if constexpr (FP8) acc[ai][bj][m][n] = __builtin_amdgcn_mfma_scale_f32_16x16x128_f8f6f4(Bt[n], At[m], acc[ai][bj][m][n], 0, 0, 0, 0x7f7f7f7f, 0, 0x7f7f7f7f); \
        else { acc[ai][bj][m][n] = __builtin_amdgcn_mfma_f32_16x16x32_bf16(__builtin_bit_cast(bf16x8, __builtin_shufflevector(Bt[n], Bt[n], 0, 1, 2, 3)), __builtin_bit_cast(bf16x8, __builtin_shufflevector(At[m], At[m], 0, 1, 2, 3)), acc[ai][bj][m][n], 0, 0, 0); \
               acc[ai][bj][m][n] = __builtin_amdgcn_mfma_f32_16x16x32_bf16(__builtin_bit_cast(bf16x8, __builtin_shufflevector(Bt[n], Bt[n], 4, 5, 6, 7)), __builtin_bit_cast(bf16x8, __builtin_shufflevector(At[m], At[m], 4, 5, 6, 7)), acc[ai][bj][m][n], 0, 0, 0); } } \
        __builtin_amdgcn_s_setprio(0); } while (0)
#define PG8_WAIT_V(n) asm volatile("s_waitcnt vmcnt(" #n ")" ::: "memory")
#define PG8_WAIT_L(n) asm volatile("s_waitcnt lgkmcnt(" #n ")" ::: "memory")
#define PG8_BAR __builtin_amdgcn_s_barrier()
#define PG8_SCHED __builtin_amdgcn_sched_barrier(0)
    Unit cur, nxt; int ui = 0;
    if (!S.next(0, cur)) return;
    f32x4 acc[2][2][4][2];
#pragma unroll
    for (int a = 0; a < 2; ++a)
#pragma unroll
        for (int b = 0; b < 2; ++b)
#pragma unroll
            for (int m = 0; m < 4; ++m)
#pragma unroll
                for (int n = 0; n < 2; ++n) acc[a][b][m][n] = (f32x4){0.f, 0.f, 0.f, 0.f};
    i32x8 At[4], B0[2], B1[2];
    const char* cA = S.a_base(cur); const char* cB = S.b_base(cur);
    if constexpr (GATHER) { const int* ix = S.a_idx(cur);
#pragma unroll
        for (int i = 0; i < 2; ++i) { int R, C; stage_rc(tid * 16 + i * 8192, R, C); vo[0][i] = (unsigned)ix[R] * (unsigned)KB + (unsigned)(C * 2); vo[1][i] = (unsigned)ix[HALF + R] * (unsigned)KB + (unsigned)(C * 2); }
        PG8_WAIT_V(0); }
    PG8_STAGEB(PG8_SB(0, 0), cB); PG8_STAGEB(PG8_SB(0, 1), cB + hstep); PG8_STAGEA(PG8_SA(0, 0), cA, vo, 0); PG8_STAGEA(PG8_SA(0, 1), cA, vo, 1);
    if (wr == 1) PG8_BAR;
    PG8_WAIT_V(2); PG8_BAR;
    PG8_STAGEB(PG8_SB(1, 0), cB + kstep); PG8_STAGEA(PG8_SA(1, 0), cA + kstep, vo, 0); PG8_STAGEB(PG8_SB(1, 1), cB + hstep + kstep);
    PG8_WAIT_V(6); PG8_BAR;
    for (;;) {
        const bool has_next = S.next(ui + 1, nxt);
        const char* nA = has_next ? S.a_base(nxt) : cA; const char* nB = has_next ? S.b_base(nxt) : cB;
        if constexpr (GATHER) { if (has_next && wid < 4) { const int ln = wid * 64 + fresh_lane();
            __builtin_amdgcn_global_load_lds((const unsigned*)(S.a_idx(nxt) + ln), (LAS unsigned*)(idxslot + wid * 256), 4, 0, 0); } }
#pragma unroll 1
        for (int t = 0; t < nt; t += 2) {
            const bool last = (t == nt - 2);
            const char* a1 = cA + (size_t)(t + 1) * kstep;
            const char* a2 = last ? nA : cA + (size_t)(t + 2) * kstep; const char* b2 = last ? nB : cB + (size_t)(t + 2) * kstep;
            const char* a3 = a2 + kstep; const char* b3 = b2 + kstep;
            PG8_LDB(B0, 0, 0); PG8_LDB(B1, 0, 1); PG8_SCHED; PG8_LDA(At, 0, 0); PG8_STAGEA(PG8_SA(1, 1), a1, vo, 1);
            PG8_WAIT_V(8); PG8_WAIT_L(0); PG8_BAR; PG8_MMA(0, 0, At, B0); PG8_MMA(0, 1, At, B1); PG8_BAR; PG8_SCHED;
            if constexpr (GATHER) { if (last && has_next) {
#pragma unroll
                for (int i = 0; i < 2; ++i) { int R, C; stage_rc((wid * 64 + fresh_lane()) * 16 + i * 8192, R, C);
                    vo[0][i] = *(const LAS unsigned*)(idxslot + R * 4) * (unsigned)KB + (unsigned)(C * 2); vo[1][i] = *(const LAS unsigned*)(idxslot + (HALF + R) * 4) * (unsigned)KB + (unsigned)(C * 2); } } }
            PG8_LDA(At, 0, 1); PG8_STAGEB(PG8_SB(0, 0), b2); PG8_STAGEB(PG8_SB(0, 1), b2 + hstep); PG8_STAGEA(PG8_SA(0, 0), a2, vo, 0);
            PG8_WAIT_V(8); PG8_WAIT_L(0); PG8_BAR; PG8_MMA(1, 0, At, B0); PG8_MMA(1, 1, At, B1); PG8_BAR; PG8_SCHED;
            PG8_LDB(B0, 1, 0); PG8_LDB(B1, 1, 1); PG8_SCHED; PG8_LDA(At, 1, 0); PG8_STAGEA(PG8_SA(0, 1), a2, vo, 1);
            PG8_WAIT_V(8); PG8_WAIT_L(0); PG8_BAR; PG8_MMA(0, 0, At, B0); PG8_MMA(0, 1, At, B1); PG8_BAR; PG8_SCHED;
            PG8_LDA(At, 1, 1); PG8_STAGEB(PG8_SB(1, 0), b3); PG8_STAGEB(PG8_SB(1, 1), b3 + hstep); PG8_STAGEA(PG8_SA(1, 0), a3, vo, 0);
            PG8_WAIT_V(8); PG8_WAIT_L(0); PG8_BAR; PG8_MMA(1, 0, At, B0); PG8_MMA(1, 1, At, B1); PG8_BAR; PG8_SCHED;
        }
        if (wr == 0) PG8_BAR;
        { const int l2 = fresh_lane(); E(acc, cur, wr, wc, l2 & 15, l2 >> 4); }
        if (!has_next) break;
#pragma unroll
        for (int a = 0; a < 2; ++a)
#pragma unroll
            for (int b = 0; b < 2; ++b)
#pragma unroll
                for (int m = 0; m < 4; ++m)
#pragma unroll
                    for (int n = 0; n < 2; ++n) acc[a][b][m][n] = (f32x4){0.f, 0.f, 0.f, 0.f};
        cur = nxt; cA = nA; cB = nB; ++ui;
        if (wr == 1) PG8_BAR;
    }
    PG8_WAIT_V(0);
    PG8_BAR;
#undef PG8_SA
#undef PG8_SB
#undef PG8_STAGEA
#undef PG8_GLDS
#undef PG8_STAGEB
#undef PG8_LDA
#undef PG8_LDB
#undef PG8_MMA
#undef PG8_WAIT_V
#undef PG8_WAIT_L
#undef PG8_BAR
#undef PG8_SCHED
}
}

__device__ __forceinline__ const float* xsrc_row(const Ctx& c, int l, int r) {
    return (r < TL) ? c.I(I_X) + (size_t)r * D : c.I(I_CTX) + (size_t)(r - TL) * D;
}
__device__ __forceinline__ int mod_row(int r) { return r < TL ? r / SEQ : 8; }

constexpr int MOD_ITEMS = 2 * (MODW / 128);
__device__ __forceinline__ void ph_mod_full(const Ctx& c) {
    lfloat* sl = (lfloat*)c.lds;
    lfloat* red = (lfloat*)c.lds;
    for (int it = c.bid; it < MOD_ITEMS; it += c.nb) {
        const int l = it / (MODW / 128), col0 = (it % (MODW / 128)) * 128;
        __syncthreads();
        { float cv[36];
          const float* cp = c.I(I_C) + c.tid; const float* xp = c.I(I_CCTX) + c.tid;
#pragma unroll
          for (int j = 0; j < 36; ++j) cv[j] = (j < 32) ? cp[(j >> 2) * D + 512 * (j & 3)] : xp[512 * (j & 3)];
#pragma unroll
          for (int j = 0; j < 36; ++j) sl[(512 * (j & 3) + c.tid) * 12 + (j >> 2)] = cv[j] * sigmoidf_(cv[j]); }
        __syncthreads();
        const int q = c.tid & 31, kg = c.tid >> 5;
        float acc[9][4];
#pragma unroll
        for (int r = 0; r < 9; ++r)
#pragma unroll
            for (int e = 0; e < 4; ++e) acc[r][e] = 0.f;
        const float* wp = c.I(I_ADAW) + ((size_t)l * D + kg) * MODW + col0 + 4 * q;
        const lfloat* sp = sl + kg * 12;
#pragma unroll 16
        for (int i = 0; i < 128; ++i) {
            const f32x4 w = __builtin_nontemporal_load((const f32x4*)(wp + (size_t)(16 * i) * MODW));
            const float4 s0 = lds_ld4(sp + i * 192), s1 = lds_ld4(sp + i * 192 + 4); const float s8 = sp[i * 192 + 8];
            const float sv[9] = {s0.x, s0.y, s0.z, s0.w, s1.x, s1.y, s1.z, s1.w, s8};
#pragma unroll
            for (int r = 0; r < 9; ++r) { acc[r][0] += sv[r] * w.x; acc[r][1] += sv[r] * w.y; acc[r][2] += sv[r] * w.z; acc[r][3] += sv[r] * w.w; }
        }
        __syncthreads();
#pragma unroll
        for (int r = 0; r < 9; ++r) lds_st4(red + (kg * 9 + r) * 128 + 4 * q, make_float4(acc[r][0], acc[r][1], acc[r][2], acc[r][3]));
        __syncthreads();
        for (int o = c.tid; o < 9 * 128; o += 512) { const int r = o >> 7, n = o & 127; float sum = c.I(I_ADAB)[l * MODW + col0 + n];
#pragma unroll
            for (int g = 0; g < 16; ++g) sum += red[(g * 9 + r) * 128 + n];
            c.mod()[(size_t)(l * 9 + r) * MODW + col0 + n] = sum; }
    }
    __syncthreads();
}

__device__ __forceinline__ void transpose_item(const float* W, int K, int N, bf16_t* WT, lfloat* scr, int item, int lane) {
    const int nblk = N / 32, kb = item / nblk, nb = item % nblk, k0 = 64 * kb, n0 = 32 * nb;
    { float tv[32]; const float* wp = W + (size_t)(k0 + (lane >> 5)) * N + n0 + (lane & 31);
#pragma unroll
      for (int i = 0; i < 32; ++i) tv[i] = wp[(size_t)(2 * i) * N];
#pragma unroll
      for (int i = 0; i < 32; ++i) scr[(2 * i + (lane >> 5)) * 33 + (lane & 31)] = tv[i]; }
    asm volatile("s_waitcnt lgkmcnt(0)" ::: "memory");
    const int cc = lane & 7;
#pragma unroll
    for (int j = 0; j < 4; ++j) { const int n = (lane >> 3) + 8 * j; const lfloat* sp = scr + (8 * cc) * 33 + n;
        uint4 o; o.x = pk2(sp[0 * 33], sp[1 * 33]); o.y = pk2(sp[2 * 33], sp[3 * 33]); o.z = pk2(sp[4 * 33], sp[5 * 33]); o.w = pk2(sp[6 * 33], sp[7 * 33]);
        *(uint4*)(WT + (size_t)(n0 + n) * K + k0 + 8 * cc) = o; }
    asm volatile("s_waitcnt lgkmcnt(0)" ::: "memory");
}
__device__ __forceinline__ void transpose_item8(const float* W, int K, int N, unsigned char* WT, lfloat* scr, int item, int lane) {
    const int nblk = N / 32, kb = item / nblk, nb = item % nblk, k0 = 128 * kb, n0 = 32 * nb;
    const float* wp = W + (size_t)(k0 + (lane >> 5)) * N + n0 + (lane & 31);
#pragma unroll
    for (int hf = 0; hf < 2; ++hf) { float tv[32];
#pragma unroll
        for (int i = 0; i < 32; ++i) tv[i] = __builtin_nontemporal_load(wp + (size_t)(64 * hf + 2 * i) * N);
#pragma unroll
        for (int i = 0; i < 32; ++i) scr[(64 * hf + 2 * i + (lane >> 5)) * 33 + (lane & 31)] = tv[i]; }
    asm volatile("s_waitcnt lgkmcnt(0)" ::: "memory");
    const int cc = lane & 7;
#pragma unroll
    for (int j = 0; j < 4; ++j) { const int n = (lane >> 3) + 8 * j; const lfloat* sp = scr + (16 * cc) * 33 + n;
        uint4 o; o.x = pk4_fp8(sp[0 * 33] * W8S, sp[1 * 33] * W8S, sp[2 * 33] * W8S, sp[3 * 33] * W8S); o.y = pk4_fp8(sp[4 * 33] * W8S, sp[5 * 33] * W8S, sp[6 * 33] * W8S, sp[7 * 33] * W8S);
        o.z = pk4_fp8(sp[8 * 33] * W8S, sp[9 * 33] * W8S, sp[10 * 33] * W8S, sp[11 * 33] * W8S); o.w = pk4_fp8(sp[12 * 33] * W8S, sp[13 * 33] * W8S, sp[14 * 33] * W8S, sp[15 * 33] * W8S);
        *(uint4*)(WT + (size_t)(n0 + n) * K + k0 + 16 * cc) = o; }
    asm volatile("s_waitcnt lgkmcnt(0)" ::: "memory");
}
constexpr int CV_E1 = (D / 128) * (D / 32), CV_E2 = (DFF / 128) * (D / 32), CV_LAYER = NE * (CV_E1 + CV_E2), CV_ALL = 2 * CV_LAYER;
__device__ __forceinline__ void expert_item(const Ctx& c, int gidx, lfloat* scr, int lane) {
    const int layer = gidx / CV_LAYER, r = gidx % CV_LAYER;
    if (r < NE * CV_E1) { const int m = layer * NE + r / CV_E1; transpose_item8(c.I(I_W1) + (size_t)m * D * D, D, D, c.ws + WS_W1T + (size_t)m * D * D, scr, r % CV_E1, lane); }
    else { const int r2 = r - NE * CV_E1, m = layer * NE + r2 / CV_E2; transpose_item8(c.I(I_W2) + (size_t)m * DFF * D, DFF, D, c.ws + WS_W2T + (size_t)m * D * DFF, scr, r2 % CV_E2, lane); }
}
constexpr int G_IN0 = 240, G_OUT0 = 192, G_IN1 = 192;
constexpr int Q_IN0 = 608, Q_OUT0 = 400, Q_IN1 = 704, Q_MIX = 48, MIX_FIRST = 64, CV_SKEW = 8;
constexpr int CVT_E = CV_ALL, CVT_C = CVT_E - (256 - G_IN1) * Q_IN1, CVT_B = CVT_C - (256 - G_OUT0) * Q_OUT0, CVT_A = CVT_B - (256 - G_IN0) * Q_IN0, CVT_M = CVT_A - (256 - MIX_FIRST) * Q_MIX;
static_assert(CVT_C >= CV_LAYER && CVT_M >= 0, "gemm_in(1)'s slice holds layer-1 items only; layer 0's items finish before moe1(0)");
static_assert(G_IN0 * 6 >= (MT / 256) * (NIN / 256) && G_OUT0 * 3 >= (MT / 256) * (D / 256) && G_IN1 * 7 >= (TL / 256) * (NIN / 256) + (TC / 256) * 6, "whole rounds");
struct CvItem { const float* src; unsigned char* dst; int K; };
__device__ __forceinline__ CvItem cv_decode(const Ctx& c, int gidx) {
    const int layer = gidx / CV_LAYER, r = gidx % CV_LAYER; const float* W; unsigned char* WT; int K, item;
    if (r < NE * CV_E1) { const int m = layer * NE + r / CV_E1; W = c.I(I_W1) + (size_t)m * D * D; WT = c.ws + WS_W1T + (size_t)m * D * D; K = D; item = r % CV_E1; }
    else { const int r2 = r - NE * CV_E1, m = layer * NE + r2 / CV_E2; W = c.I(I_W2) + (size_t)m * DFF * D; WT = c.ws + WS_W2T + (size_t)m * D * DFF; K = DFF; item = r2 % CV_E2; }
    const int kb = item / (D / 32), nb = item % (D / 32);
    return CvItem{W + (size_t)(128 * kb) * D + 32 * nb, WT + (size_t)(32 * nb) * K + 128 * kb, K};
}
#define CV_LOAD(TV, IT) do { const float* _p = (IT).src + (size_t)(16 * (lane >> 3)) * D + 4 * (lane & 7); _Pragma("unroll") for (int _i = 0; _i < 16; ++_i) TV[_i] = __builtin_nontemporal_load((const f32x4*)(_p + (size_t)_i * D)); } while (0)
__device__ __forceinline__ void cv_process(const f32x4 (&tv)[16], const CvItem& it, int lane) {
    unsigned char* d = it.dst + (size_t)(4 * (lane & 7)) * it.K + 16 * (lane >> 3);
#pragma unroll
    for (int e = 0; e < 4; ++e) { uint4 o;
        o.x = pk4_fp8(tv[0][e] * W8S, tv[1][e] * W8S, tv[2][e] * W8S, tv[3][e] * W8S); o.y = pk4_fp8(tv[4][e] * W8S, tv[5][e] * W8S, tv[6][e] * W8S, tv[7][e] * W8S);
        o.z = pk4_fp8(tv[8][e] * W8S, tv[9][e] * W8S, tv[10][e] * W8S, tv[11][e] * W8S); o.w = pk4_fp8(tv[12][e] * W8S, tv[13][e] * W8S, tv[14][e] * W8S, tv[15][e] * W8S);
        *(uint4*)(d + (size_t)e * it.K) = o; }
}
__device__ __forceinline__ void tail_convert(const Ctx& c, int base, int q) {
    lfloat* scr = (lfloat*)(c.lds + c.wave * 16896);
    const int lane = (int)__builtin_amdgcn_mbcnt_hi(~0u, __builtin_amdgcn_mbcnt_lo(~0u, 0u));
    const int n = q / 8; int g = base + c.wave;
    f32x4 ta[16], tb[16];
    { const CvItem i0 = cv_decode(c, g); CV_LOAD(ta, i0); }
#pragma unroll 1
    for (int j = 0; j < n; j += 2) {
        { int gb = g + 8; asm volatile("" : "+s"(gb)); const CvItem ib = cv_decode(c, gb); CV_LOAD(tb, ib); }
        { int ga = g; asm volatile("" : "+s"(ga)); const CvItem ia = cv_decode(c, ga); cv_process(ta, ia, lane); }
        { int gn = (j + 2 < n) ? g + 16 : g; asm volatile("" : "+s"(gn)); const CvItem in = cv_decode(c, gn); CV_LOAD(ta, in); }
        { int gb = g + 8; asm volatile("" : "+s"(gb)); const CvItem ib = cv_decode(c, gb); cv_process(tb, ib, lane); }
        g += 16;
    }
}
__device__ __forceinline__ void ph_convert(const Ctx& c) {
    lfloat* scr = (lfloat*)(c.lds + c.wave * 16896);
    const int gw = c.bid * 8 + c.wave, NGW = c.nb * 8;
    constexpr int I_IN = (D / 64) * (NIN / 32), I_OUT = (D / 64) * (D / 32);
    constexpr int N_IN = 2 * I_IN, N_OUT = 2 * I_OUT;
    const int N_EX = (c.nb == 256) ? CVT_M : CV_ALL;
    const int nfree = (c.nb > MOD_ITEMS) ? (c.nb - MOD_ITEMS) * 8 : 0, NSK = nfree * CV_SKEW, NTOT = N_IN + N_OUT + N_EX;
    const int fw = (c.bid - MOD_ITEMS) * 8 + c.wave;
    int it = (fw >= 0 && nfree) ? fw : NSK + gw;
    while (it < NTOT) {
        int r = it;
        it = (it < NSK) ? ((it + nfree < NSK) ? it + nfree : NSK + gw) : it + NGW;
        if (r < N_IN) { const int m = r / I_IN; transpose_item(c.I(I_WIN) + (size_t)m * D * NIN, D, NIN, (bf16_t*)(c.ws + WS_WIN) + (size_t)m * NIN * D, scr, r % I_IN, c.lane); continue; } r -= N_IN;
        if (r < N_OUT) { const int m = r / I_OUT; transpose_item(c.I(I_WOUT) + (size_t)m * D * D, D, D, (bf16_t*)(c.ws + WS_WOUT) + (size_t)m * D * D, scr, r % I_OUT, c.lane); continue; } r -= N_OUT;
        expert_item(c, r, scr, c.lane);
    }
}

__device__ __forceinline__ void ph_norm1(const Ctx& c, int l) {
    const float* g = c.I(I_N1G) + l * D;
    for (int r = c.bid * 8 + c.wave; r < MT; r += c.nb * 8) {
        const float4* src = (const float4*)xsrc_row(c, l, r);
        float4 v[8]; float ss = 0.f;
#pragma unroll
        for (int j = 0; j < 8; ++j) { v[j] = src[j * 64 + c.lane]; ss += v[j].x * v[j].x + v[j].y * v[j].y + v[j].z * v[j].z + v[j].w * v[j].w; }
        const float rstd = rsqrtf(wave_sum(ss) * (1.f / D) + EPS);
        const float* m = c.mod() + (size_t)(l * 9 + mod_row(r)) * MODW;
        bf16_t* o = c.H() + (size_t)r * D; bf16_t* xb = c.XB() + (size_t)r * D;
#pragma unroll
        for (int j = 0; j < 8; ++j) {
            const int col = (j * 64 + c.lane) * 4;
            *(uint2*)(xb + col) = make_uint2(pk2(v[j].x, v[j].y), pk2(v[j].z, v[j].w));
            const float4 gg = *(const float4*)(g + col), sc = *(const float4*)(m + 1 * D + col), sh = *(const float4*)(m + 0 * D + col);
            const float o0 = v[j].x * rstd * gg.x * (1.f + sc.x) + sh.x, o1 = v[j].y * rstd * gg.y * (1.f + sc.y) + sh.y;
            const float o2 = v[j].z * rstd * gg.z * (1.f + sc.z) + sh.z, o3 = v[j].w * rstd * gg.w * (1.f + sc.w) + sh.w;
            *(uint2*)(o + col) = make_uint2(pk2(o0, o1), pk2(o2, o3));
        }
    }
}

__device__ __forceinline__ float swiglu_act(float g, float up) {
    g = fminf(g, 7.f); up = fminf(fmaxf(up, -7.f), 7.f);
    return (up + 1.f) * (g * sigmoidf_(1.702f * g));
}
using pg8::f32x4; using pg8::Unit;
struct SchedIn { const char* A; const char* Bt; int l, G, c;
    __device__ __forceinline__ bool next(int i, Unit& u) const {
        const int Ge = (G == 256) ? (l == 0 ? G_IN0 : G_IN1) : G;
        const int L = i * Ge + c, nLat = (TL / 256) * (NIN / 256);
        if (l == 0) { if (L >= (MT / 256) * (NIN / 256)) return false; int pm, pn; pg8::tile_order(L, MT / 256, NIN / 256, pm, pn); u.row0 = pm * 256; u.col0 = pn * 256; u.e = 0; return true; }
        if (L >= nLat + (TC / 256) * 6) return false;
        if (L < nLat) { int pm, pn; pg8::tile_order(L, TL / 256, NIN / 256, pm, pn); u.row0 = pm * 256; u.col0 = pn * 256; u.e = 0; return true; }
        const int r = L - nLat, j = r % 6; u.row0 = TL + (r / 6) * 256; u.col0 = ((j < 4) ? 6 + j : 14 + j) * 256; u.e = 0; return true;
    }
    __device__ __forceinline__ const char* a_base(const Unit& u) const { return A + (size_t)u.row0 * D * 2; }
    __device__ __forceinline__ const int* a_idx(const Unit&) const { return nullptr; }
    __device__ __forceinline__ const char* b_base(const Unit& u) const { return Bt + (size_t)u.col0 * D * 2; }
};
struct EpiU { static constexpr bool PERM = true; bf16_t* U;
    __device__ __forceinline__ void operator()(const f32x4 (&acc)[2][2][4][2], const Unit& u, int wr, int wc, int fr, int fq) const {
        const bool rope = (u.col0 >= 1024 && u.col0 < 2048 && u.row0 < TL);
        float inv[8];
#pragma unroll
        for (int j = 0; j < 8; ++j) inv[j] = exp2f(-(float)(8 * (fq & 1) + j) * (13.287712379549449f / 16.f));
        const bool first = fq < 2; const int ax = wc & 1;
#pragma unroll
        for (int ai = 0; ai < 2; ++ai)
#pragma unroll
            for (int m = 0; m < 4; ++m) {
                const int row = u.row0 + ai * 128 + wr * 64 + m * 16 + fr;
                const unsigned roff = (unsigned)(row * NIN + u.col0 + wc * 32 + 8 * fq) * 2u;
                float cs[8], sn[8];
                if (rope) { const int t = row & (SEQ - 1); const float pp = ax ? (float)(t & 63) : (float)(t >> 6);
#pragma unroll
                    for (int j = 0; j < 8; ++j) { const float ang = pp * inv[j]; cs[j] = __cosf(ang); sn[j] = first ? -__sinf(ang) : __sinf(ang); } }
#pragma unroll
                for (int bj = 0; bj < 2; ++bj) { f32x4 v0 = acc[ai][bj][m][0], v1 = acc[ai][bj][m][1];
                    if (rope) { f32x4 p0, p1;
#pragma unroll
                        for (int q = 0; q < 4; ++q) { p0[q] = __shfl_xor(v0[q], 32); p1[q] = __shfl_xor(v1[q], 32); }
#pragma unroll
                        for (int q = 0; q < 4; ++q) { v0[q] = v0[q] * cs[q] + p0[q] * sn[q]; v1[q] = v1[q] * cs[4 + q] + p1[q] * sn[4 + q]; } }
                    pg8::u32x4 w; w.x = pg8::cvt_pk_bf16(v0[0], v0[1]); w.y = pg8::cvt_pk_bf16(v0[2], v0[3]); w.z = pg8::cvt_pk_bf16(v1[0], v1[1]); w.w = pg8::cvt_pk_bf16(v1[2], v1[3]);
                    *(pg8::u32x4*)((char*)U + (roff + bj * 256)) = w; } }
    }
};
__device__ __forceinline__ void ph_gemm_in(const Ctx& c, int l) {
    SchedIn S{(const char*)c.H(), (const char*)(c.ws + WS_WIN) + (size_t)l * NIN * D * 2, l, c.nb, c.bid};
    EpiU E{c.U()};
    pg8::gemm_phase<D * 2, false, false>(c.lds, c.lds + LDS_IDX, S, E, c.tid);
}
struct SchedOut { const char* A; const char* Bt; int nM, G, c;
    __device__ __forceinline__ bool next(int i, Unit& u) const { const int Ge = (G == 256 && nM == MT / 256) ? G_OUT0 : G; const int L = i * Ge + c; if (L >= nM * (D / 256)) return false; int pm, pn; pg8::tile_order(L, nM, D / 256, pm, pn); u.row0 = pm * 256; u.col0 = pn * 256; u.e = 0; return true; }
    __device__ __forceinline__ const char* a_base(const Unit& u) const { return A + (size_t)u.row0 * D * 2; }
    __device__ __forceinline__ const int* a_idx(const Unit&) const { return nullptr; }
    __device__ __forceinline__ const char* b_base(const Unit& u) const { return Bt + (size_t)u.col0 * D * 2; }
};
struct EpiX1 { static constexpr bool PERM = true; const Ctx* c; int l; bf16_t* X1;
    __device__ __forceinline__ void operator()(const f32x4 (&acc)[2][2][4][2], const Unit& u, int wr, int wc, int fr, int fq) const {
        const char* xin = (const char*)c->XB();
        const int colq = u.col0 + wc * 32 + 8 * fq, rowq = u.row0 + wr * 64 + fr;
        f32x4 g1v[2][2];
        { const char* g1p = (const char*)c->mod(); const unsigned goff = (unsigned)((l * 9 + mod_row(u.row0)) * MODW + 2 * D + colq) * 4u;
#pragma unroll
          for (int bj = 0; bj < 2; ++bj) { g1v[bj][0] = *(const f32x4*)(g1p + (goff + bj * 512)); g1v[bj][1] = *(const f32x4*)(g1p + (goff + bj * 512 + 16)); } }
#pragma unroll
        for (int gi = 0; gi < 8; ++gi) {
            const int ai = gi >> 2, m = gi & 3; const unsigned eoff = (unsigned)((rowq + ai * 128 + m * 16) * D + colq) * 2u;
#pragma unroll
            for (int bj = 0; bj < 2; ++bj) { const pg8::u32x4 xv = *(const pg8::u32x4*)(xin + (eoff + bj * 256));
                const f32x4 x0 = (f32x4){__uint_as_float(xv.x << 16), __uint_as_float(xv.x & 0xffff0000u), __uint_as_float(xv.y << 16), __uint_as_float(xv.y & 0xffff0000u)};
                const f32x4 x1 = (f32x4){__uint_as_float(xv.z << 16), __uint_as_float(xv.z & 0xffff0000u), __uint_as_float(xv.w << 16), __uint_as_float(xv.w & 0xffff0000u)};
                const f32x4 v0 = x0 + g1v[bj][0] * acc[ai][bj][m][0], v1 = x1 + g1v[bj][1] * acc[ai][bj][m][1];
                pg8::u32x4 w; w.x = pg8::cvt_pk_bf16(v0[0], v0[1]); w.y = pg8::cvt_pk_bf16(v0[2], v0[3]); w.z = pg8::cvt_pk_bf16(v1[0], v1[1]); w.w = pg8::cvt_pk_bf16(v1[2], v1[3]);
                *(pg8::u32x4*)((char*)X1 + (eoff + bj * 256)) = w; }
        }
    }
};
__device__ __forceinline__ void ph_gemm_out(const Ctx& c, int l) {
    SchedOut S{(const char*)c.YM(), (const char*)(c.ws + WS_WOUT) + (size_t)l * D * D * 2, (l == 0 ? MT : TL) / 256, c.nb, c.bid};
    EpiX1 E{&c, l, c.XA()};
    pg8::gemm_phase<D * 2, false, false>(c.lds, c.lds + LDS_IDX, S, E, c.tid);
}

__device__ __forceinline__ void tile_rows(int tile, int& rowbase, int& L, int& t0) {
    if (tile < TL / 32) { const int b = tile / (SEQ / 32); rowbase = b * SEQ; L = SEQ; t0 = (tile % (SEQ / 32)) * 32; }
    else { const int tc = tile - TL / 32, b = tc / (CTXL / 32); rowbase = TL + b * CTXL; L = CTXL; t0 = (tc % (CTXL / 32)) * 32; }
}
typedef unsigned u32x4_t __attribute__((ext_vector_type(4)));
__device__ __forceinline__ void unpack8(const u32x4_t v, float (&f)[8]) {
#pragma unroll
    for (int i = 0; i < 4; ++i) { f[2 * i] = __uint_as_float(v[i] << 16); f[2 * i + 1] = __uint_as_float(v[i] & 0xffff0000u); }
}
__device__ __forceinline__ void conva_item(const Ctx& c, int l, int tile) {
    lfloat* zs = (lfloat*)c.lds;
    const int tid = c.tid; int rowbase, L, t0; tile_rows(tile, rowbase, L, t0);
    const char* U = (const char*)c.U();
    __syncthreads();
#pragma unroll
    for (int p = 0; p < 8; ++p) { const int idx = p * 512 + tid, rr = idx >> 6, g = idx & 63, t = t0 - 15 + rr;
        { float z[8];
            { const bool ok = (t >= 0 && t < L); const int tc = ok ? t : t0;
                const unsigned off = (unsigned)((rowbase + tc) * NIN + g * 8) * 2u; const u32x4_t vv = *(const u32x4_t*)(U + off), gg = *(const u32x4_t*)(U + off + 1024u);
                float vf[8], gf[8]; unpack8(vv, vf); unpack8(gg, gf); const float mk = ok ? 1.f : 0.f;
#pragma unroll
                for (int i = 0; i < 8; ++i) z[i] = mk * vf[i] * sigmoidf_(gf[i]); }
            lds_st4(zs + rr * 512 + g * 8, make_float4(z[0], z[1], z[2], z[3])); lds_st4(zs + rr * 512 + g * 8 + 4, make_float4(z[4], z[5], z[6], z[7])); } }
    __syncthreads();
    { const int ch = tid; float zr[62], w[31];
      { const float* wb = c.I(I_CAW) + (size_t)l * 31 * GW + ch; asm volatile("" : "+v"(wb));
#pragma unroll
        for (int k = 0; k < 31; ++k) w[k] = wb[k * GW]; }
#pragma unroll
      for (int r = 0; r < 62; ++r) zr[r] = zs[r * 512 + ch];
      const float cb = c.I(I_CAB)[l * GW + ch];
#pragma unroll
      for (int r = 0; r < 32; ++r) { float acc = cb;
#pragma unroll
          for (int k = 0; k < 31; ++k) acc += w[k] * zr[r + k];
          zs[r * 512 + ch] = acc; } }
    __syncthreads();
    { const int lane = c.lane, wave = c.wave; const float* gp = c.I(I_LNAG) + l * GW + lane * 8; const float* bp = c.I(I_LNAB) + l * GW + lane * 8;
      const float4 g0 = *(const float4*)gp, g1 = *(const float4*)(gp + 4), b0 = *(const float4*)bp, b1 = *(const float4*)(bp + 4);
      const float gg[8] = {g0.x, g0.y, g0.z, g0.w, g1.x, g1.y, g1.z, g1.w}, bb[8] = {b0.x, b0.y, b0.z, b0.w, b1.x, b1.y, b1.z, b1.w};
#pragma unroll
      for (int q = 0; q < 4; ++q) { const int r = wave * 4 + q; const float4 v0 = lds_ld4(zs + r * 512 + lane * 8), v1 = lds_ld4(zs + r * 512 + lane * 8 + 4);
          float v[8] = {v0.x, v0.y, v0.z, v0.w, v1.x, v1.y, v1.z, v1.w}; float sm = 0.f;
#pragma unroll
          for (int i = 0; i < 8; ++i) sm += v[i];
          const float mu = wave_sum(sm) * (1.f / GW); float sq = 0.f;
#pragma unroll
          for (int i = 0; i < 8; ++i) { v[i] -= mu; sq += v[i] * v[i]; }
          const float rstd = rsqrtf(wave_sum(sq) * (1.f / GW) + EPS);
#pragma unroll
          for (int i = 0; i < 8; ++i) { const float y = v[i] * rstd * gg[i] + bb[i]; v[i] = y * sigmoidf_(y); }
          *(uint4*)((char*)c.YM() + (unsigned)((rowbase + t0 + r) * D + lane * 8) * 2u) = make_uint4(pk2(v[0], v[1]), pk2(v[2], v[3]), pk2(v[4], v[5]), pk2(v[6], v[7])); } }
}
__device__ __forceinline__ void convc_item(const Ctx& c, int l, int tile) {
    const int lane = c.lane, wave = c.wave; int rowbase, L, t0; tile_rows(tile, rowbase, L, t0);
    const char* U = (const char*)c.U();
    float w0[8], w1[8], w2[8], gn[8];
    { const float* wp = c.I(I_CCW) + (size_t)l * 3 * GW + lane * 8; const float* gp = c.I(I_NCG) + l * GW + lane * 8;
#pragma unroll
      for (int i = 0; i < 8; ++i) { w0[i] = wp[i]; w1[i] = wp[GW + i]; w2[i] = wp[2 * GW + i]; gn[i] = gp[i]; } }
    const int tw = t0 + wave * 4;
    u32x4_t cgr[6], vvr[6], bgr[4]; float mk[6];
#pragma unroll
    for (int k = 0; k < 6; ++k) { const int tt = tw - 1 + k; const bool ok = (tt >= 0 && tt < L); const unsigned o2 = (unsigned)((rowbase + (ok ? tt : tw)) * NIN + 2560 + lane * 8) * 2u; mk[k] = ok ? 1.f : 0.f;
        cgr[k] = *(const u32x4_t*)(U + o2 + 1024u); vvr[k] = *(const u32x4_t*)(U + o2 + 2048u); }
#pragma unroll
    for (int q = 0; q < 4; ++q) bgr[q] = *(const u32x4_t*)(U + (unsigned)((rowbase + tw + q) * NIN + 2560 + lane * 8) * 2u);
    float p[6][8];
#pragma unroll
    for (int k = 0; k < 6; ++k) { float cg[8], vv[8]; unpack8(cgr[k], cg); unpack8(vvr[k], vv);
#pragma unroll
        for (int i = 0; i < 8; ++i) p[k][i] = mk[k] * cg[i] * vv[i]; }
#pragma unroll
    for (int q = 0; q < 4; ++q) { float y[8], bg[8]; unpack8(bgr[q], bg); float sq = 0.f;
#pragma unroll
        for (int i = 0; i < 8; ++i) { y[i] = bg[i] * (w0[i] * p[q][i] + w1[i] * p[q + 1][i] + w2[i] * p[q + 2][i]); sq += y[i] * y[i]; }
        const float rstd = rsqrtf(wave_sum(sq) * (1.f / GW) + EPS);
#pragma unroll
        for (int i = 0; i < 8; ++i) y[i] *= rstd * gn[i];
        *(uint4*)((char*)c.YM() + (unsigned)((rowbase + tw + q) * D + 1024 + lane * 8) * 2u) = make_uint4(pk2(y[0], y[1]), pk2(y[2], y[3]), pk2(y[4], y[5]), pk2(y[6], y[7])); }
}
__device__ __forceinline__ float gelu_tanh(float x) { const float u = 0.7978845608028654f * (x + 0.044715f * x * x * x); const float e = __expf(2.f * u); return x * (1.f - __builtin_amdgcn_rcpf(e + 1.f)); }
namespace lru {
using bf16x8 = __attribute__((ext_vector_type(8))) short;
using f32x16 = __attribute__((ext_vector_type(16))) float;
__device__ __forceinline__ int crow(int r, int hi) { return (r & 3) + 8 * (r >> 2) + 4 * hi; }
__device__ __forceinline__ bf16x8 ident_frag(int ks, int nt, int n, int hi) {
    const int e0 = 32 * nt + n - 16 * ks - 8 * hi; bf16x8 v;
#pragma unroll
    for (int e = 0; e < 8; ++e) v[e] = (e == e0) ? (short)0x3F80 : (short)0;
    return v;
}
template <int MODE, int DIR>
__device__ __forceinline__ void lru_dir(const Ctx& c, int l, const char* U, const bf16_t* WG, float* SP, lfloat* yl, int b, int cidx, int rowbase, int L, int t0, int blk, int n, int hi) {
    const int ld = l * 2 + DIR; const bool is_ctx = cidx < NCC;
    float pin0 = 0.f, pin1 = 0.f;
    if constexpr (MODE == 1) {
        const char* spb = (const char*)(SP + ((size_t)(DIR * NB + b) * NCHUNK) * 2 * GW); const unsigned cho = (unsigned)(blk * 64 + n) * 4u;
        int n1, s1, n2 = 0, s2 = 0;
        if (DIR == 0) { s1 = 0; n1 = cidx; } else if (is_ctx) { s1 = NCC - 1; n1 = NCC - 1 - cidx; } else { s1 = NCC - 1; n1 = NCC; s2 = NCHUNK - 1; n2 = NCHUNK - 1 - cidx; }
        constexpr int STEP = DIR == 0 ? 1 : -1;
#pragma unroll 1
        for (int run = 0; run < 2; ++run) { const int st = run ? s2 : s1, nn = run ? n2 : n1;
#pragma unroll 1
            for (int k0 = 0; k0 < nn; k0 += 8) { float fa0[8], fb0[8], fa1[8], fb1[8];
#pragma unroll
                for (int k = 0; k < 8; ++k) { const bool ok = k0 + k < nn; const unsigned co = (unsigned)((ok ? st + STEP * (k0 + k) : st) * 2 * GW) * 4u + cho;
                    const float a0 = *(const float*)(spb + co), b0 = *(const float*)(spb + (co + GW * 4u)), a1 = *(const float*)(spb + (co + 128u)), b1 = *(const float*)(spb + (co + GW * 4u + 128u));
                    fa0[k] = ok ? a0 : 1.f; fb0[k] = ok ? b0 : 0.f; fa1[k] = ok ? a1 : 1.f; fb1[k] = ok ? b1 : 0.f; }
#pragma unroll
                for (int k = 0; k < 8; ++k) { pin0 = fa0[k] * pin0 + fb0[k]; pin1 = fa1[k] * pin1 + fb1[k]; } } }
    }
    bf16x8 af[2][4];
#pragma unroll
    for (int ks = 0; ks < 4; ++ks) {
        const int c0 = blk * 64 + 16 * ks + 8 * hi;
        float cw[4][8], cb[8];
        { const float* wp = c.I(I_LCW) + (size_t)ld * 4 * GW + c0; const float* bp = c.I(I_LCB) + ld * GW + c0;
#pragma unroll
          for (int k = 0; k < 4; ++k) { const float4 w0 = *(const float4*)(wp + k * GW), w1 = *(const float4*)(wp + k * GW + 4); cw[k][0] = w0.x; cw[k][1] = w0.y; cw[k][2] = w0.z; cw[k][3] = w0.w; cw[k][4] = w1.x; cw[k][5] = w1.y; cw[k][6] = w1.z; cw[k][7] = w1.w; }
          const float4 b0 = *(const float4*)bp, b1 = *(const float4*)(bp + 4); cb[0] = b0.x; cb[1] = b0.y; cb[2] = b0.z; cb[3] = b0.w; cb[4] = b1.x; cb[5] = b1.y; cb[6] = b1.z; cb[7] = b1.w; }
#pragma unroll
        for (int rt = 0; rt < 2; ++rt) { const int t = t0 + rt * 32 + n; float acc[8];
#pragma unroll
            for (int i = 0; i < 8; ++i) acc[i] = cb[i];
#pragma unroll
            for (int k = 0; k < 4; ++k) { const int tt = t + k - (DIR == 0 ? 3 : 0);
                const bool ok = (tt >= 0 && tt < L); const int tc = ok ? tt : t; const float mk = ok ? 1.f : 0.f;
                float x[8]; unpack8(*(const u32x4_t*)(U + (unsigned)((rowbase + tc) * NIN + 4608 + c0) * 2u), x);
#pragma unroll
                for (int i = 0; i < 8; ++i) acc[i] += (mk * cw[k][i]) * x[i]; }
            u32x4_t pk; pk[0] = pk2(acc[0], acc[1]); pk[1] = pk2(acc[2], acc[3]); pk[2] = pk2(acc[4], acc[5]); pk[3] = pk2(acc[6], acc[7]);
            af[rt][ks] = __builtin_bit_cast(bf16x8, pk); }
    }
#pragma unroll 1
    for (int nt = 0; nt < 2; ++nt) {
        const int ch = blk * 64 + nt * 32 + n;
        f32x16 accA[2], accX[2], accV[2];
#pragma unroll
        for (int rt = 0; rt < 2; ++rt) { accA[rt] = f32x16{}; accX[rt] = f32x16{}; accV[rt] = f32x16{}; }
        { const bf16_t* wa = WG + ((size_t)((ld * 2 + 0) * 8 + blk) * 64 + nt * 32 + n) * 64 + 8 * hi; const bf16_t* wx = wa + 8 * 64 * 64;
#pragma unroll
          for (int ks = 0; ks < 4; ++ks) { const bf16x8 bA = *(const bf16x8*)(wa + 16 * ks), bX = *(const bf16x8*)(wx + 16 * ks), bI = ident_frag(ks, nt, n, hi);
#pragma unroll
              for (int rt = 0; rt < 2; ++rt) { accA[rt] = __builtin_amdgcn_mfma_f32_32x32x16_bf16(af[rt][ks], bA, accA[rt], 0, 0, 0); accX[rt] = __builtin_amdgcn_mfma_f32_32x32x16_bf16(af[rt][ks], bX, accX[rt], 0, 0, 0);
                  accV[rt] = __builtin_amdgcn_mfma_f32_32x32x16_bf16(af[rt][ks], bI, accV[rt], 0, 0, 0); } } }
        { const float bav = c.I(I_LBA)[ld * GW + ch], bxv = c.I(I_LBX)[ld * GW + ch], lamv = c.I(I_LLAM)[ld * GW + ch];
          const float sp8 = -8.f * 1.4426950408889634f * log1pf(__expf(-lamv));
#pragma unroll
          for (int rt = 0; rt < 2; ++rt)
#pragma unroll
            for (int r = 0; r < 16; ++r) { const float rg = sigmoidf_(accA[rt][r] + bav), ig = sigmoidf_(accX[rt][r] + bxv); const float a = __builtin_amdgcn_exp2f(rg * sp8);
                accA[rt][r] = a; accX[rt][r] = __builtin_amdgcn_sqrtf(fmaxf(fmaf(-a, a, 1.f), 0.f)) * (ig * accV[rt][r]); } }
        float cA[2][4], cB[2][4], pA[2][4], pB[2][4];
#pragma unroll
        for (int rt = 0; rt < 2; ++rt)
#pragma unroll
            for (int q = 0; q < 4; ++q) { const float a0 = accA[rt][4 * q + (DIR ? 3 : 0)], a1 = accA[rt][4 * q + (DIR ? 2 : 1)], a2 = accA[rt][4 * q + (DIR ? 1 : 2)], a3 = accA[rt][4 * q + (DIR ? 0 : 3)];
                const float b0 = accX[rt][4 * q + (DIR ? 3 : 0)], b1 = accX[rt][4 * q + (DIR ? 2 : 1)], b2 = accX[rt][4 * q + (DIR ? 1 : 2)], b3 = accX[rt][4 * q + (DIR ? 0 : 3)];
                cA[rt][q] = (a0 * a1) * (a2 * a3); cB[rt][q] = ((b0 * a1 + b1) * a2 + b2) * a3 + b3;
                pA[rt][q] = __shfl_xor(cA[rt][q], 32); pB[rt][q] = __shfl_xor(cB[rt][q], 32); }
        float p = (MODE == 1) ? (nt == 0 ? pin0 : pin1) : 0.f, aprod = 1.f;
        float hs[16];
#pragma unroll
        for (int s2 = 0; s2 < 16; ++s2) { const int k = DIR ? 15 - s2 : s2, rt = k >> 3, q = (k >> 1) & 3; const bool own = ((k & 1) == hi);
            const float Ak = own ? cA[rt][q] : pA[rt][q], Bk = own ? cB[rt][q] : pB[rt][q];
            hs[k] = p; p = Ak * p + Bk; aprod *= Ak; }
        if constexpr (MODE == 0) { if (hi == 0) { float* spo = SP + ((size_t)((DIR * NB + b) * NCHUNK + cidx)) * 2 * GW + ch; spo[0] = aprod; spo[GW] = p; } }
        else {
#pragma unroll
            for (int rt = 0; rt < 2; ++rt)
#pragma unroll
                for (int q = 0; q < 4; ++q) { float h = hi ? hs[2 * q + 1 + 8 * rt] : hs[2 * q + 8 * rt];
#pragma unroll
                    for (int e = 0; e < 4; ++e) { const int r = 4 * q + (DIR ? 3 - e : e); h = accA[rt][r] * h + accX[rt][r]; lfloat* yp = yl + ((nt * 2 + rt) * 16 + r) * 512; if (DIR == 0) *yp = h; else *yp += h; } }
        }
    }
}
template <int MODE> __device__ __forceinline__ void lru_item(const Ctx& c, int l, int b, int cidx) {
    const int blk = c.wave, n = c.lane & 31, hi = c.lane >> 5;
    const bool is_ctx = cidx < NCC;
    const int L = is_ctx ? CTXL : SEQ, t0 = (is_ctx ? cidx : cidx - NCC) * 64, rowbase = is_ctx ? TL + b * CTXL : b * SEQ;
    const char* U = (const char*)c.U(); const bf16_t* WG = (const bf16_t*)(c.ws + WS_WG); float* SP = (float*)(c.ws + WS_SP);
    if constexpr (MODE == 1) __syncthreads();
    lfloat* yl = (lfloat*)c.lds + c.tid;
    lru_dir<MODE, 0>(c, l, U, WG, SP, yl, b, cidx, rowbase, L, t0, blk, n, hi);
    lru_dir<MODE, 1>(c, l, U, WG, SP, yl, b, cidx, rowbase, L, t0, blk, n, hi);
    if constexpr (MODE == 1) {
        lfloat* red = (lfloat*)(c.lds + LDS_MISC);
#pragma unroll 1
        for (int nt = 0; nt < 2; ++nt) { f32x16 accG[2];
#pragma unroll
            for (int rt = 0; rt < 2; ++rt) accG[rt] = f32x16{};
#pragma unroll
            for (int ks = 0; ks < 4; ++ks) { const bf16x8 bI = ident_frag(ks, nt, n, hi);
#pragma unroll
                for (int rt = 0; rt < 2; ++rt) { const bf16x8 ga = *(const bf16x8*)(U + (unsigned)((rowbase + t0 + rt * 32 + n) * NIN + 4096 + blk * 64 + 16 * ks + 8 * hi) * 2u);
                    accG[rt] = __builtin_amdgcn_mfma_f32_32x32x16_bf16(ga, bI, accG[rt], 0, 0, 0); } }
#pragma unroll
            for (int rt = 0; rt < 2; ++rt)
#pragma unroll
                for (int r = 0; r < 16; ++r) yl[((nt * 2 + rt) * 16 + r) * 512] *= gelu_tanh(accG[rt][r]); }
        float yall[2][2][16];
#pragma unroll
        for (int nt = 0; nt < 2; ++nt)
#pragma unroll
            for (int rt = 0; rt < 2; ++rt)
#pragma unroll
                for (int r = 0; r < 16; ++r) yall[nt][rt][r] = yl[((nt * 2 + rt) * 16 + r) * 512];
        __syncthreads();
#pragma unroll
        for (int rt = 0; rt < 2; ++rt)
#pragma unroll
            for (int r = 0; r < 16; ++r) { float sq = yall[0][rt][r] * yall[0][rt][r] + yall[1][rt][r] * yall[1][rt][r];
                sq += __shfl_xor(sq, 1); sq += __shfl_xor(sq, 2); sq += __shfl_xor(sq, 4); sq += __shfl_xor(sq, 8); sq += __shfl_xor(sq, 16);
                if (n == 0) red[blk * 64 + rt * 32 + crow(r, hi)] = sq; }
        __syncthreads();
        if (c.tid < 64) { float t = 0.f;
#pragma unroll
            for (int w = 0; w < 8; ++w) t += red[w * 64 + c.tid];
            red[512 + c.tid] = rsqrtf(t * (1.f / GW) + EPS); }
        __syncthreads();
        const float g0 = c.I(I_NDG)[l * GW + blk * 64 + n], g1 = c.I(I_NDG)[l * GW + blk * 64 + 32 + n];
        char* YMc = (char*)c.YM();
        LAS char* stg = (LAS char*)c.lds + blk * (64 * 144);
#pragma unroll
        for (int rt = 0; rt < 2; ++rt)
#pragma unroll
            for (int r = 0; r < 16; ++r) { const int row = rt * 32 + crow(r, hi); const float rs = red[512 + row];
                *(LAS bf16_t*)(stg + row * 144 + n * 2) = (bf16_t)f2bf(yall[0][rt][r] * rs * g0); *(LAS bf16_t*)(stg + row * 144 + (32 + n) * 2) = (bf16_t)f2bf(yall[1][rt][r] * rs * g1); }
        asm volatile("s_waitcnt lgkmcnt(0)" ::: "memory");
#pragma unroll
        for (int it = 0; it < 8; ++it) { const int q = it * 64 + (int)c.lane, row = q >> 3, c16 = q & 7;
            const u32x4_t v = *(const LAS u32x4_t*)(stg + row * 144 + c16 * 16);
            *(u32x4_t*)(YMc + (unsigned)((rowbase + t0 + row) * D + 1536 + blk * 64 + c16 * 8) * 2u) = v; }
    }
}
}

__device__ __forceinline__ void ph_convert_router(const Ctx& c) {
    uint4* RWF = (uint4*)(c.ws + WS_RWF);
    for (int idx = c.bid * 512 + c.tid; idx < 2 * 8 * 8 * 2 * 64; idx += c.nb * 512) {
        const int lane = idx & 63, nt = (idx >> 6) & 1, ks = (idx >> 7) & 7, w = (idx >> 10) & 7, l = idx >> 13, fr = lane & 15, fq = lane >> 4;
        const float* rwp = c.I(I_RW) + ((size_t)l * D + w * 256 + 32 * ks + 8 * fq) * NE + 16 * nt + fr;
        unsigned hi[4], lo[4];
#pragma unroll
        for (int j2 = 0; j2 < 4; ++j2) { const float w0 = rwp[(size_t)(2 * j2) * NE], w1 = rwp[(size_t)(2 * j2 + 1) * NE]; const unsigned h0 = f2bf(w0), h1 = f2bf(w1);
            hi[j2] = h0 | (h1 << 16); lo[j2] = pk2(w0 - __uint_as_float(h0 << 16), w1 - __uint_as_float(h1 << 16)); }
        RWF[(size_t)(idx >> 6) * 128 + lane] = make_uint4(hi[0], hi[1], hi[2], hi[3]); RWF[(size_t)(idx >> 6) * 128 + 64 + lane] = make_uint4(lo[0], lo[1], lo[2], lo[3]);
    }
}
__device__ __forceinline__ void ph_convert_lru(const Ctx& c) {
    bf16_t* WG = (bf16_t*)(c.ws + WS_WG);
    for (int idx = c.bid * 512 + c.tid; idx < 4 * 2 * 8 * 64 * 64; idx += c.nb * 512) {
        const int i = idx & 63, j = (idx >> 6) & 63, blk = (idx >> 12) & 7, g = (idx >> 15) & 1, ld = idx >> 16;
        const float* src = (g == 0) ? c.I(I_LWA) : c.I(I_LWX);
        WG[idx] = (bf16_t)f2bf(src[((size_t)(ld * 8 + blk) * 64 + i) * 64 + j]);
    }
}

namespace att {
using bf16x8 = __attribute__((ext_vector_type(8))) short;
using s16x4  = __attribute__((ext_vector_type(4))) short;
using f32x16 = __attribute__((ext_vector_type(16))) float;
using u32x4  = __attribute__((ext_vector_type(4))) unsigned;
constexpr int SHM_V = 64 * 128 * 2, SHM_K = 64 * 64 * 2, OFF_K = 2 * SHM_V, OFF_W = OFF_K + 2 * SHM_K, OFF_STG = OFF_W + 8 * 256, LDS_NEED = OFF_STG + 8 * 32 * 272;
static_assert(LDS_NEED <= 131072, "attention LDS");
constexpr float SCALE = 0.125f, THR = 8.f;
#define K64SWZ(row, colB) ((row) * 128 + ((colB) ^ ((((row) >> 1) & 7) << 4)))
#define SBAR() __builtin_amdgcn_sched_barrier(0)
__device__ __forceinline__ int crow(int r, int hi) { return (r & 3) + 8 * (r >> 2) + 4 * hi; }
__device__ __forceinline__ unsigned cvtpk(float lo, float hi) { unsigned r; asm volatile("v_cvt_pk_bf16_f32 %0, %1, %2" : "=v"(r) : "v"(lo), "v"(hi)); return r; }
__device__ __forceinline__ void partialSM(f32x16& p0, f32x16& p1, float& m_reg, float& mn, float& alpha) {
    constexpr float C = SCALE * 1.4426950408889634f;
    float pmax = p0[0];
#pragma unroll
    for (int r = 1; r < 16; ++r) pmax = fmaxf(pmax, p0[r]);
#pragma unroll
    for (int r = 0; r < 16; ++r) pmax = fmaxf(pmax, p1[r]);
    { auto rr = __builtin_amdgcn_permlane32_swap(__float_as_uint(pmax), __float_as_uint(pmax), false, false); pmax = fmaxf(__uint_as_float(rr[0]), __uint_as_float(rr[1])); }
    if (__builtin_expect(__all(pmax - m_reg <= THR / SCALE), 1)) { mn = m_reg; alpha = 1.f; }
    else { mn = fmaxf(m_reg, pmax); alpha = __builtin_amdgcn_exp2f((m_reg - mn) * C); m_reg = mn; }
    const float mnC = -mn * C;
#pragma unroll
    for (int r = 0; r < 16; ++r) p0[r] = fmaf(p0[r], C, mnC);
#pragma unroll
    for (int r = 0; r < 16; ++r) p1[r] = fmaf(p1[r], C, mnC);
#pragma unroll
    for (int r = 0; r < 16; ++r) p0[r] = __builtin_amdgcn_exp2f(p0[r]);
}
__device__ __forceinline__ void finishSM(f32x16& p0, f32x16& p1, float alpha, float& l_reg, bf16x8& pa0, bf16x8& pa1, bf16x8& pa2, bf16x8& pa3) {
#pragma unroll
    for (int r = 0; r < 16; ++r) p1[r] = __builtin_amdgcn_exp2f(p1[r]);
    float ps = 0;
#pragma unroll
    for (int r = 0; r < 16; ++r) ps += p0[r];
#pragma unroll
    for (int r = 0; r < 16; ++r) ps += p1[r];
    { auto rr = __builtin_amdgcn_permlane32_swap(__float_as_uint(ps), __float_as_uint(ps), false, false); ps = __uint_as_float(rr[0]) + __uint_as_float(rr[1]); }
    l_reg = l_reg * alpha + ps;
#define PK4(P, BASE, OUT) do { unsigned a0 = cvtpk(P[BASE + 0], P[BASE + 1]), a1 = cvtpk(P[BASE + 2], P[BASE + 3]);   \
    unsigned b0 = cvtpk(P[BASE + 4], P[BASE + 5]), b1 = cvtpk(P[BASE + 6], P[BASE + 7]);                              \
    auto r0 = __builtin_amdgcn_permlane32_swap(a0, b0, false, false); auto r1 = __builtin_amdgcn_permlane32_swap(a1, b1, false, false); \
    u32x4 w = {r0[0], r1[0], r0[1], r1[1]}; OUT = __builtin_bit_cast(bf16x8, w); } while (0)
    PK4(p0, 0, pa0); PK4(p0, 8, pa1); PK4(p1, 0, pa2); PK4(p1, 8, pa3);
#undef PK4
}
__device__ __forceinline__ void qkt(f32x16& p0, f32x16& p1, const LAS char* Ks, const bf16x8* qr, int r32, int hi) {
    p0 = f32x16{}; p1 = f32x16{};
#pragma unroll
    for (int d0 = 0; d0 < 4; ++d0) { const int cb = (d0 * 16 + hi * 8) * 2;
        const bf16x8 b0 = *(const LAS bf16x8*)(Ks + K64SWZ(r32, cb));
        const bf16x8 b1 = *(const LAS bf16x8*)(Ks + K64SWZ(32 + r32, cb));
        p0 = __builtin_amdgcn_mfma_f32_32x32x16_bf16(b0, qr[d0], p0, 0, 0, 0);
        p1 = __builtin_amdgcn_mfma_f32_32x32x16_bf16(b1, qr[d0], p1, 0, 0, 0); }
}
__device__ __forceinline__ int v_st(int k, int c) { const int kk = (k & ~0xC) | ((k & 4) << 1) | ((k & 8) >> 1); return ((kk >> 3) * 4 + (c >> 5)) * 512 + ((kk & 7) * 32 + (c & 31)) * 2; }
__device__ __forceinline__ int v_rd_base(int lane) { return ((lane & 3) << 3) | (((lane >> 2) & 3) << 6) | (((lane >> 4) & 1) << 5) | (((lane >> 5) & 1) << 8); }
constexpr int v_rd_off(int d0, int ks, int half) { return d0 * 512 + ks * 4096 + half * 2048; }
template <int OFF> __device__ __forceinline__ s16x4 tr_read(int vb) { s16x4 r; asm volatile("ds_read_b64_tr_b16 %0, %1 offset:%2" : "=&v"(r) : "v"(vb), "i"(OFF) : "memory"); return r; }
template <int D0> __device__ __forceinline__ void pv_one(f32x16& od, int vb, bf16x8 pa0, bf16x8 pa1, bf16x8 pa2, bf16x8 pa3) {
    const s16x4 l0 = tr_read<v_rd_off(D0, 0, 0)>(vb), h0 = tr_read<v_rd_off(D0, 0, 1)>(vb), l1 = tr_read<v_rd_off(D0, 1, 0)>(vb), h1 = tr_read<v_rd_off(D0, 1, 1)>(vb);
    const s16x4 l2 = tr_read<v_rd_off(D0, 2, 0)>(vb), h2 = tr_read<v_rd_off(D0, 2, 1)>(vb), l3 = tr_read<v_rd_off(D0, 3, 0)>(vb), h3 = tr_read<v_rd_off(D0, 3, 1)>(vb);
    asm volatile("s_waitcnt lgkmcnt(0)" ::: "memory"); SBAR();
#define PK(L, H) (bf16x8){L[0], L[1], L[2], L[3], H[0], H[1], H[2], H[3]}
    od = __builtin_amdgcn_mfma_f32_32x32x16_bf16(pa0, PK(l0, h0), od, 0, 0, 0);
    od = __builtin_amdgcn_mfma_f32_32x32x16_bf16(pa1, PK(l1, h1), od, 0, 0, 0);
    od = __builtin_amdgcn_mfma_f32_32x32x16_bf16(pa2, PK(l2, h2), od, 0, 0, 0);
    od = __builtin_amdgcn_mfma_f32_32x32x16_bf16(pa3, PK(l3, h3), od, 0, 0, 0);
#undef PK
}
__device__ __forceinline__ void pv_d0(f32x16* o, int vb, bf16x8 pa0, bf16x8 pa1, bf16x8 pa2, bf16x8 pa3) {
    pv_one<0>(o[0], vb, pa0, pa1, pa2, pa3); pv_one<1>(o[1], vb, pa0, pa1, pa2, pa3); pv_one<2>(o[2], vb, pa0, pa1, pa2, pa3); pv_one<3>(o[3], vb, pa0, pa1, pa2, pa3);
}
template <bool GA> __device__ __forceinline__ void attn_unit(const bf16_t* __restrict__ U, bf16_t* __restrict__ YM, float* __restrict__ stash, const float* __restrict__ ng, float lam, float lam_init,
                                          int qrow0, int b, int dh, int NT, LAS char* lds, int wid) {
    const int lane = pg8::fresh_lane(), tid = wid * 64 + lane, r32 = lane & 31, hi = lane >> 5;
    LAS char* V_lds = lds; LAS char* K_lds = lds + OFF_K;
    LAS float* wsl = (LAS float*)(lds + OFF_W) + wid * 64; LAS float* li_l = wsl; LAS float* al_l = wsl + 32;
    const int sr = tid >> 4, sc = (tid & 15) * 8, vst0 = v_st(sr, sc), vst1 = v_st(32 + sr, sc);
    const int kr = tid >> 3, kc = (tid & 7) * 8, kst = K64SWZ(kr, kc * 2);
    const int vb0 = (int)(unsigned)(size_t)V_lds + v_rd_base(lane);
    const int krow_ctx = TL + b * CTXL, krow_lat = b * SEQ - 4 * 64;
    f32x16 o[4];
#pragma unroll 1
    for (int jm = 0; jm < 2; ++jm) {
        const int hq = 2 * dh + jm;
        const unsigned koff = (unsigned)(kr * NIN + 1536 + hq * 64 + kc) * 2u, voff = (unsigned)(sr * NIN + 2048 + dh * 128 + sc) * 2u;
        float m_reg = -1e30f, l_reg = 0.f; bf16x8 qr[4];
#pragma unroll
        for (int d = 0; d < 4; ++d) o[d] = f32x16{};
        { const unsigned qoff = (unsigned)((qrow0 + wid * 32 + r32) * NIN + 1024 + hq * 64 + hi * 8) * 2u;
#pragma unroll
          for (int d0 = 0; d0 < 4; ++d0) qr[d0] = *(const bf16x8*)((const char*)U + (qoff + d0 * 32)); }
        struct { bf16x8 vs0, vs1, ks; } sr_[2];
#define KROW(kt) (((kt) < 4 ? krow_ctx : krow_lat) + (kt) * 64)
#define SLOAD(i, kt) do { const unsigned _r = (unsigned)KROW(kt) * (unsigned)(NIN * 2); sr_[i].vs0 = *(const bf16x8*)((const char*)U + (_r + voff)); sr_[i].vs1 = *(const bf16x8*)((const char*)U + (_r + voff + 32u * NIN * 2u)); \
        sr_[i].ks = *(const bf16x8*)((const char*)U + (_r + koff)); } while (0)
#define SWRITE(bf, i) do { *(LAS bf16x8*)(V_lds + (bf) * SHM_V + vst0) = sr_[i].vs0; *(LAS bf16x8*)(V_lds + (bf) * SHM_V + vst1) = sr_[i].vs1; \
        *(LAS bf16x8*)(K_lds + (bf) * SHM_K + kst) = sr_[i].ks; } while (0)
#define SWAIT() asm volatile("s_waitcnt vmcnt(3)" ::: "memory")
#define RESC(a) do { if (__any((a) < 1.f)) { if (hi == 0) al_l[r32] = (a); asm volatile("s_waitcnt lgkmcnt(0)" ::: "memory"); \
        _Pragma("unroll") for (int d = 0; d < 4; ++d) _Pragma("unroll") for (int r = 0; r < 16; ++r) o[d][r] *= al_l[crow(r, hi)]; } } while (0)
        f32x16 pA0, pA1, pB0, pB1; float mnA, mnB, alA, alB; bf16x8 pa0, pa1, pa2, pa3;
        constexpr int SE = 0, SO = 1;
        __syncthreads();
        SLOAD(SE, 0); asm volatile("s_waitcnt vmcnt(0)" ::: "memory"); SWRITE(0, SE); __syncthreads();
        qkt(pA0, pA1, K_lds, qr, r32, hi); partialSM(pA0, pA1, m_reg, mnA, alA);
        SLOAD(SO, 1); if (2 < NT) SLOAD(SE, 2);
        SWAIT(); SWRITE(1, SO); __syncthreads();
        if constexpr (GA) {
#pragma unroll 1
            for (int j = 1; j + 1 < NT; j += 2) {
                SBAR(); qkt(pB0, pB1, K_lds + SHM_K, qr, r32, hi); SBAR(); finishSM(pA0, pA1, alA, l_reg, pa0, pa1, pa2, pa3); SBAR();
                SLOAD(SO, j + 2); SBAR();
                pv_d0(o, vb0, pa0, pa1, pa2, pa3); SBAR(); partialSM(pB0, pB1, m_reg, mnB, alB);
                __syncthreads(); SWAIT(); SWRITE(0, SE);
                RESC(alB); __syncthreads();
                SBAR(); qkt(pA0, pA1, K_lds, qr, r32, hi); SBAR(); finishSM(pB0, pB1, alB, l_reg, pa0, pa1, pa2, pa3); SBAR();
                if (j + 3 < NT) SLOAD(SE, j + 3); SBAR();
                pv_d0(o, vb0 + SHM_V, pa0, pa1, pa2, pa3); SBAR(); partialSM(pA0, pA1, m_reg, mnA, alA);
                __syncthreads(); SWAIT(); SWRITE(1, SO);
                RESC(alA); __syncthreads();
            }
        } else {
#pragma unroll 1
            for (int j = 1; j + 1 < NT; j += 2) {
                SBAR(); finishSM(pA0, pA1, alA, l_reg, pa0, pa1, pa2, pa3); SBAR(); qkt(pB0, pB1, K_lds + SHM_K, qr, r32, hi); SBAR();
                SLOAD(SO, j + 2); SBAR();
                partialSM(pB0, pB1, m_reg, mnB, alB); SBAR(); pv_d0(o, vb0, pa0, pa1, pa2, pa3);
                __syncthreads(); SWAIT(); SWRITE(0, SE);
                RESC(alB); __syncthreads();
                SBAR(); finishSM(pB0, pB1, alB, l_reg, pa0, pa1, pa2, pa3); SBAR(); qkt(pA0, pA1, K_lds, qr, r32, hi); SBAR();
                if (j + 3 < NT) SLOAD(SE, j + 3); SBAR();
                partialSM(pA0, pA1, m_reg, mnA, alA); SBAR(); pv_d0(o, vb0 + SHM_V, pa0, pa1, pa2, pa3);
                __syncthreads(); SWAIT(); SWRITE(1, SO);
                RESC(alA); __syncthreads();
            }
        }
        SBAR(); qkt(pB0, pB1, K_lds + SHM_K, qr, r32, hi);
        finishSM(pA0, pA1, alA, l_reg, pa0, pa1, pa2, pa3); SBAR();
        pv_d0(o, vb0, pa0, pa1, pa2, pa3); partialSM(pB0, pB1, m_reg, mnB, alB);
        __syncthreads(); RESC(alB);
        finishSM(pB0, pB1, alB, l_reg, pa0, pa1, pa2, pa3); SBAR();
        pv_d0(o, vb0 + SHM_V, pa0, pa1, pa2, pa3);
        if (hi == 0) li_l[r32] = l_reg; asm volatile("s_waitcnt lgkmcnt(0)" ::: "memory");
#pragma unroll
        for (int r = 0; r < 16; ++r) { const float rl = __builtin_amdgcn_rcpf(li_l[crow(r, hi)]);
#pragma unroll
            for (int d = 0; d < 4; ++d) o[d][r] *= rl; }
        if (jm == 0) {
            unsigned so = (unsigned)tid * 16u;
#pragma unroll
            for (int d = 0; d < 4; ++d)
#pragma unroll
                for (int q4 = 0; q4 < 4; ++q4) { *(f32x4*)((char*)stash + so) = (f32x4){o[d][q4 * 4 + 0], o[d][q4 * 4 + 1], o[d][q4 * 4 + 2], o[d][q4 * 4 + 3]}; so += 8192u; asm volatile("" : "+v"(so)); }
        }
#undef KROW
#undef SLOAD
#undef SWRITE
#undef SWAIT
#undef RESC
    }
    float ss[16];
    const int lane_e = pg8::fresh_lane(), r32e = lane_e & 31, hie = lane_e >> 5, wide = __builtin_amdgcn_readfirstlane(wid);
    { unsigned so = (unsigned)(wide * 64 + lane_e) * 16u;
#pragma unroll
      for (int d = 0; d < 4; ++d)
#pragma unroll
        for (int q4 = 0; q4 < 4; ++q4) { const f32x4 s0 = *(const f32x4*)((const char*)stash + so); so += 8192u; asm volatile("" : "+v"(so));
#pragma unroll
            for (int e = 0; e < 4; ++e) o[d][q4 * 4 + e] = s0[e] - lam * o[d][q4 * 4 + e]; } }
#pragma unroll
    for (int r = 0; r < 16; ++r) { float a = 0.f;
#pragma unroll
        for (int d = 0; d < 4; ++d) a += o[d][r] * o[d][r];
        a += __shfl_xor(a, 1); a += __shfl_xor(a, 2); a += __shfl_xor(a, 4); a += __shfl_xor(a, 8); a += __shfl_xor(a, 16);
        ss[r] = rsqrtf(a * (1.f / 128.f) + EPS) * (1.f - lam_init); }
    float gv[4];
#pragma unroll
    for (int d = 0; d < 4; ++d) gv[d] = ng[32 * d + r32e];
    LAS char* stg = lds + OFF_STG + wide * (32 * 272);
#pragma unroll
    for (int r = 0; r < 16; ++r)
#pragma unroll
        for (int d = 0; d < 4; ++d) *(LAS bf16_t*)(stg + crow(r, hie) * 272 + (32 * d + r32e) * 2) = (bf16_t)f2bf(o[d][r] * ss[r] * gv[d]);
    asm volatile("s_waitcnt lgkmcnt(0)" ::: "memory");
#pragma unroll
    for (int it = 0; it < 8; ++it) { const int q = it * 64 + lane_e, row = q >> 4, c16 = q & 15;
        const u32x4 v = *(const LAS u32x4*)(stg + row * 272 + c16 * 16);
        *(u32x4*)((char*)YM + (unsigned)((qrow0 + wide * 32 + row) * D + 512 + dh * 128 + c16 * 8) * 2u) = v; }
}
#undef K64SWZ
#undef SBAR
}
__device__ __forceinline__ float lam_init_of(int l) { return l == 0 ? 0.2f : 0.35550906759096927f; }
__device__ __forceinline__ void ph_attention(const Ctx& c, int l) {
    float lam; { const float* lv = c.I(I_DLAM) + l * 4 * 64; float s0 = 0.f, s1 = 0.f; for (int i = 0; i < 64; ++i) { s0 += lv[i] * lv[64 + i]; s1 += lv[128 + i] * lv[192 + i]; } lam = __expf(s0) - __expf(s1) + lam_init_of(l); }
    float* stash = (float*)(c.ws + WS_OST) + (size_t)c.bid * 512 * 64;
    const float* ng = c.I(I_DNG) + l * 128;
    const int nlat = NB * 4 * (SEQ / 256), total = nlat + (l == 0 ? NB * 4 : 0);
    for (int it = c.bid; it < total; it += c.nb) {
        int b, dh, qrow0, NT;
        if (it < nlat) { b = it / 32; dh = (it / 8) & 3; qrow0 = b * SEQ + (it & 7) * 256; NT = 36; }
        else { const int r = it - nlat; b = r >> 2; dh = r & 3; qrow0 = TL + b * CTXL; NT = 4; }
        if ((c.wave & 1) == 0) att::attn_unit<true>(c.U(), c.YM(), stash, ng, lam, lam_init_of(l), qrow0, b, dh, NT, (LAS char*)c.lds, c.wave);
        else att::attn_unit<false>(c.U(), c.YM(), stash, ng, lam, lam_init_of(l), qrow0, b, dh, NT, (LAS char*)c.lds, c.wave);
    }
}

__device__ __forceinline__ void ph_norm2_router(const Ctx& c, int l) {
    typedef short bf16x8 __attribute__((ext_vector_type(8)));
    const int rows = (l == 0) ? MT : TL;
    const float* g = c.I(I_N2G) + l * D;
    const char* X1 = (const char*)c.XA();
    int* topi = (int*)(c.ws + WS_TOPI); float* gate = (float*)(c.ws + WS_GATE);
    unsigned* cnt = c.ctl() + CW_CNT + l * 32 * 64;
    constexpr int RS = 4096 + 16;
    LAS unsigned char* HH = c.lds; LAS unsigned char* HL = c.lds + 16 * RS;
    lfloat* part = (lfloat*)c.lds;
    lfloat* logit = (lfloat*)(c.lds + 2 * 16 * RS);
    lint* lcnt = (lint*)(c.lds + 2 * 16 * RS + 2048);
    if (c.tid < 32) lcnt[c.tid] = 0;
    __syncthreads();
    const int kb = c.wave * 256, fr = c.lane & 15, fq = c.lane >> 4;
    const char* rwf = (const char*)(c.ws + WS_RWF) + (size_t)(l * 8 + c.wave) * 8 * 2 * 2 * 1024;
    u32x4_t v[2][4];
    { const int r = c.bid * 16 + c.wave * 2; if (r < rows) {
#pragma unroll
        for (int i = 0; i < 2; ++i)
#pragma unroll
            for (int j = 0; j < 4; ++j) v[i][j] = *(const u32x4_t*)(X1 + (unsigned)((r + i) * D + (j * 64 + c.lane) * 8) * 2u); } }
    for (int r0 = c.bid * 16; r0 < rows; r0 += c.nb * 16) {
#pragma unroll
        for (int i = 0; i < 2; ++i) {
            const int rl = c.wave * 2 + i, r = r0 + rl;
            float ss = 0.f;
#pragma unroll
            for (int j = 0; j < 4; ++j) { float x[8]; unpack8(v[i][j], x);
#pragma unroll
                for (int q = 0; q < 8; ++q) ss += x[q] * x[q]; }
            const float rstd = rsqrtf(wave_sum(ss) * (1.f / D) + EPS);
            const float* m = c.mod() + (size_t)(l * 9 + mod_row(r)) * MODW;
            unsigned char* o = c.ws + WS_H8 + (size_t)r * D;
#pragma unroll
            for (int j = 0; j < 4; ++j) {
                const int col = (j * 64 + c.lane) * 8; float h[8], x[8]; unpack8(v[i][j], x);
#pragma unroll
                for (int q = 0; q < 2; ++q) { const unsigned co = (unsigned)(col + 4 * q) * 4u;
                    const float4 gg = *(const float4*)((const char*)g + co), sc = *(const float4*)((const char*)(m + 4 * D) + co), sh = *(const float4*)((const char*)(m + 3 * D) + co);
                    h[4 * q + 0] = x[4 * q + 0] * rstd * gg.x * (1.f + sc.x) + sh.x; h[4 * q + 1] = x[4 * q + 1] * rstd * gg.y * (1.f + sc.y) + sh.y;
                    h[4 * q + 2] = x[4 * q + 2] * rstd * gg.z * (1.f + sc.z) + sh.z; h[4 * q + 3] = x[4 * q + 3] * rstd * gg.w * (1.f + sc.w) + sh.w; }
                *(uint2*)(o + (unsigned)col) = make_uint2(pk4_fp8(h[0], h[1], h[2], h[3]), pk4_fp8(h[4], h[5], h[6], h[7]));
                u32x4_t th, tl;
#pragma unroll
                for (int q = 0; q < 4; ++q) { const unsigned a0 = f2bf(h[2 * q]), a1 = f2bf(h[2 * q + 1]); th[q] = a0 | (a1 << 16); tl[q] = pk2(h[2 * q] - __uint_as_float(a0 << 16), h[2 * q + 1] - __uint_as_float(a1 << 16)); }
                *(LAS u32x4_t*)(HH + rl * RS + col * 2) = th; *(LAS u32x4_t*)(HL + rl * RS + col * 2) = tl;
            }
            const int rn = r + c.nb * 16;
            if (rn < rows) {
#pragma unroll
                for (int j = 0; j < 4; ++j) v[i][j] = *(const u32x4_t*)(X1 + (unsigned)(rn * D + (j * 64 + c.lane) * 8) * 2u); }
            __builtin_amdgcn_sched_barrier(0);
        }
        bf16x8 bwh[8][2], bwl[8][2];
        { const unsigned lo16 = (unsigned)pg8::fresh_lane() * 16u;
#pragma unroll
          for (int ks = 0; ks < 8; ++ks)
#pragma unroll
            for (int nt = 0; nt < 2; ++nt) { bwh[ks][nt] = *(const bf16x8*)(rwf + ((ks * 2 + nt) * 2048 + lo16)); bwl[ks][nt] = *(const bf16x8*)(rwf + ((ks * 2 + nt) * 2048 + 1024 + lo16)); } }
        __syncthreads();
        f32x4 acc[2] = {(f32x4){0.f, 0.f, 0.f, 0.f}, (f32x4){0.f, 0.f, 0.f, 0.f}};
#pragma unroll
        for (int ks = 0; ks < 8; ++ks) { const int off = fr * RS + (kb + 32 * ks + 8 * fq) * 2;
            const bf16x8 ah = *(const LAS bf16x8*)(HH + off), al = *(const LAS bf16x8*)(HL + off);
#pragma unroll
            for (int nt = 0; nt < 2; ++nt) { acc[nt] = __builtin_amdgcn_mfma_f32_16x16x32_bf16(ah, bwh[ks][nt], acc[nt], 0, 0, 0); acc[nt] = __builtin_amdgcn_mfma_f32_16x16x32_bf16(ah, bwl[ks][nt], acc[nt], 0, 0, 0);
                acc[nt] = __builtin_amdgcn_mfma_f32_16x16x32_bf16(al, bwh[ks][nt], acc[nt], 0, 0, 0); } }
        __syncthreads();
#pragma unroll
        for (int nt = 0; nt < 2; ++nt)
#pragma unroll
            for (int q = 0; q < 4; ++q) part[(c.wave * 16 + 4 * fq + q) * 32 + 16 * nt + fr] = acc[nt][q];
        __syncthreads();
        { const int t3 = c.wave * 64 + pg8::fresh_lane(), rr = t3 >> 5, ee = t3 & 31; float sacc = c.I(I_RB)[l * NE + ee];
#pragma unroll
          for (int w = 0; w < 8; ++w) sacc += part[(w * 16 + rr) * 32 + ee];
          logit[rr * 32 + ee] = sacc; }
        __syncthreads();
        {
            const int ln = pg8::fresh_lane(), hh = ln >> 5, ee = ln & 31, rl = c.wave * 2 + hh, r = r0 + rl;
            float mine = logit[rl * 32 + ee]; float tv[4]; int ti[4];
#pragma unroll
            for (int k = 0; k < 4; ++k) { float mx = mine; mx = fmaxf(mx, __shfl_xor(mx, 1)); mx = fmaxf(mx, __shfl_xor(mx, 2)); mx = fmaxf(mx, __shfl_xor(mx, 4)); mx = fmaxf(mx, __shfl_xor(mx, 8)); mx = fmaxf(mx, __shfl_xor(mx, 16));
                const unsigned long long bal = __ballot(mine == mx); const unsigned mybits = hh ? (unsigned)(bal >> 32) : (unsigned)bal; const int idx = __ffs((int)mybits) - 1; tv[k] = mx; ti[k] = idx; if (ee == idx) mine = -3e38f; }
            const float e1 = __expf(tv[1] - tv[0]), e2 = __expf(tv[2] - tv[0]), e3 = __expf(tv[3] - tv[0]), inv = 1.f / (1.f + e1 + e2 + e3);
            if (ee == 0) { *(int4*)(topi + (size_t)r * 4) = make_int4(ti[0], ti[1], ti[2], ti[3]); *(float4*)(gate + (size_t)r * 4) = make_float4(inv, e1 * inv, e2 * inv, e3 * inv); }
            if (ee < 4) { const int ex = ee == 0 ? ti[0] : ee == 1 ? ti[1] : ee == 2 ? ti[2] : ti[3]; __hip_atomic_fetch_add(lcnt + ex, 1, __ATOMIC_RELAXED, __HIP_MEMORY_SCOPE_WORKGROUP); }
        }
    }
    __syncthreads();
    { const int t2 = c.wave * 64 + (int)__builtin_amdgcn_mbcnt_hi(~0u, __builtin_amdgcn_mbcnt_lo(~0u, 0u));
      if (t2 < 32 && c.flag == 0) { const int n = lcnt[t2]; if (n) atomicAdd(cnt + t2 * 64, (unsigned)n); } }
}
__device__ __forceinline__ void moe_tables(const Ctx& c, int l, lint* tab) {
    const unsigned* cnt = c.ctl() + CW_CNT + l * 32 * 64;
    __syncthreads();
    if (c.tid < 32) tab[c.tid] = (int)__hip_atomic_load(cnt + c.tid * 64, __ATOMIC_RELAXED, __HIP_MEMORY_SCOPE_AGENT);
    __syncthreads();
    if (c.tid == 0) { int so = 0, to = 0; for (int e = 0; e < 32; ++e) { const int n = tab[e]; tab[32 + e] = so; tab[64 + e] = to; const int nt = (n + 255) >> 8; so += nt * 256; to += nt; } tab[96] = to; }
    __syncthreads();
    if (c.tid < 32) { const int t0 = tab[64 + c.tid], t1 = (c.tid == 31) ? tab[96] : tab[65 + c.tid]; for (int t = t0; t < t1; ++t) tab[128 + t] = c.tid; }
    __syncthreads();
}
__device__ __forceinline__ void ph_slots(const Ctx& c, int l) {
    lint* tab = (lint*)(c.lds + LDS_MISC);
    lint* lc = tab + 512;
    moe_tables(c, l, tab);
    const int total = ((l == 0) ? MT : TL) * 4;
    const int* topi = (const int*)(c.ws + WS_TOPI); int* tslot = (int*)(c.ws + WS_TSLOT); int* stok = (int*)(c.ws + WS_STOK);
    unsigned* fill = c.ctl() + CW_FILL + l * 32 * 64;
    for (int i0 = c.bid * 512; i0 < total; i0 += c.nb * 512) {
        const int i = i0 + c.tid;
        if (c.tid < 32) lc[c.tid] = 0;
        __syncthreads();
        int e = 0, pos = 0;
        if (i < total) { e = topi[i]; pos = __hip_atomic_fetch_add(lc + e, 1, __ATOMIC_RELAXED, __HIP_MEMORY_SCOPE_WORKGROUP); }
        __syncthreads();
        if (c.tid < 32) { const int n = lc[c.tid]; lc[32 + c.tid] = n ? (int)atomicAdd(fill + c.tid * 64, (unsigned)n) : 0; }
        __syncthreads();
        if (i < total) { const int slot = tab[32 + e] + lc[32 + e] + pos; tslot[i] = slot; stok[slot] = i >> 2; }
        __syncthreads();
    }
    if (c.bid == c.nb - 1) for (int e = 0; e < 32; ++e) { const int n = tab[e], s0 = tab[32 + e], np = ((n + 255) >> 8) << 8; for (int sidx = n + c.tid; sidx < np; sidx += 512) stok[s0 + sidx] = 0; }
}
__device__ __forceinline__ int tile_expert(const lint* tab, int tile) { return tab[128 + tile]; }
template <int KB> struct SchedMoe { const char* A; const int* stok; const char* Bt; const lint* tab; int G, c;
    __device__ __forceinline__ bool next(int i, Unit& u) const { const int L = i * G + c, nT = __builtin_amdgcn_readfirstlane(tab[96]); if (L >= nT * (D / 256)) return false; int pm, pn; pg8::tile_order(L, nT, D / 256, pm, pn); u.row0 = pm * 256; u.col0 = pn * 256;
        u.e = __builtin_amdgcn_readfirstlane(tile_expert(tab, pm)); return true; }
    __device__ __forceinline__ const char* a_base(const Unit& u) const { return stok ? A : A + (size_t)u.row0 * KB; }
    __device__ __forceinline__ const int* a_idx(const Unit& u) const { return stok + u.row0; }
    __device__ __forceinline__ const char* b_base(const Unit& u) const { return Bt + ((size_t)u.e * D + u.col0) * KB; }
};
struct EpiAct { static constexpr bool PERM = true; const float* b1; unsigned char* ACT8;
    __device__ __forceinline__ void operator()(const f32x4 (&acc)[2][2][4][2], const Unit& u, int wr, int wc, int fr, int fq) const {
        const int colb = u.col0 + wc * 32 + 8 * fq; const unsigned boff = (unsigned)(u.e * D + colb) * 4u;
#pragma unroll
        for (int bj = 0; bj < 2; ++bj) { const f32x4 b0 = *(const f32x4*)((const char*)b1 + (boff + bj * 512)), b1v = *(const f32x4*)((const char*)b1 + (boff + bj * 512 + 16));
#pragma unroll
            for (int ai = 0; ai < 2; ++ai)
#pragma unroll
                for (int m = 0; m < 4; ++m) { const int row = u.row0 + ai * 128 + wr * 64 + m * 16 + fr; const unsigned off = (unsigned)(row * DFF + (colb >> 1) + bj * 64);
                    const f32x4 v0 = acc[ai][bj][m][0] * (1.f / W8S) + b0, v1 = acc[ai][bj][m][1] * (1.f / W8S) + b1v;
                    *(unsigned*)(ACT8 + off) = pk4_fp8(swiglu_act(v0[0], v0[1]), swiglu_act(v0[2], v0[3]), swiglu_act(v1[0], v1[1]), swiglu_act(v1[2], v1[3])); } }
    }
};
struct EpiOS { static constexpr bool PERM = true; const float* b2; unsigned char* OS8;
    __device__ __forceinline__ void operator()(const f32x4 (&acc)[2][2][4][2], const Unit& u, int wr, int wc, int fr, int fq) const {
        const int colb = u.col0 + wc * 32 + 8 * fq; const unsigned boff = (unsigned)(u.e * D + colb) * 4u;
#pragma unroll
        for (int bj = 0; bj < 2; ++bj) { const f32x4 b0 = *(const f32x4*)((const char*)b2 + (boff + bj * 512)), b1v = *(const f32x4*)((const char*)b2 + (boff + bj * 512 + 16));
#pragma unroll
            for (int ai = 0; ai < 2; ++ai)
#pragma unroll
                for (int m = 0; m < 4; ++m) { const int row = u.row0 + ai * 128 + wr * 64 + m * 16 + fr; const unsigned off = (unsigned)(row * D + colb + bj * 128);
                    const f32x4 v0 = acc[ai][bj][m][0] * (1.f / W8S) + b0, v1 = acc[ai][bj][m][1] * (1.f / W8S) + b1v;
                    pg8::u32x2 w; w.x = pk4_fp8(v0[0], v0[1], v0[2], v0[3]); w.y = pk4_fp8(v1[0], v1[1], v1[2], v1[3]);
                    *(pg8::u32x2*)(OS8 + off) = w; } }
    }
};
__device__ __forceinline__ void ph_moe1(const Ctx& c, int l) {
    lint* tab = (lint*)(c.lds + LDS_MISC);
    moe_tables(c, l, tab);
    SchedMoe<D> S{(const char*)(c.ws + WS_H8), (const int*)(c.ws + WS_STOK), (const char*)(c.ws + WS_W1T) + (size_t)l * NE * D * D, tab, c.nb, c.bid};
    EpiAct E{c.I(I_B1) + (size_t)l * NE * D, c.ws + WS_ACT};
    pg8::gemm_phase<D, true, true>(c.lds, c.lds + LDS_IDX, S, E, c.tid);
}
__device__ __forceinline__ void ph_moe2(const Ctx& c, int l) {
    lint* tab = (lint*)(c.lds + LDS_MISC);
    moe_tables(c, l, tab);
    SchedMoe<DFF> S{(const char*)(c.ws + WS_ACT), nullptr, (const char*)(c.ws + WS_W2T) + (size_t)l * NE * D * DFF, tab, c.nb, c.bid};
    EpiOS E{c.I(I_B2) + (size_t)l * NE * D, c.ws + WS_OS};
    pg8::gemm_phase<DFF, false, true>(c.lds, c.lds + LDS_IDX, S, E, c.tid);
}
__device__ __forceinline__ void unpack8_fp8(const uint2 v, float (&f)[8]) {
    typedef float f2 __attribute__((ext_vector_type(2)));
    const f2 a = __builtin_amdgcn_cvt_pk_f32_fp8((int)v.x, false), b = __builtin_amdgcn_cvt_pk_f32_fp8((int)v.x, true), c2 = __builtin_amdgcn_cvt_pk_f32_fp8((int)v.y, false), d = __builtin_amdgcn_cvt_pk_f32_fp8((int)v.y, true);
    f[0] = a.x; f[1] = a.y; f[2] = b.x; f[3] = b.y; f[4] = c2.x; f[5] = c2.y; f[6] = d.x; f[7] = d.y;
}
__device__ __forceinline__ void ph_combine(const Ctx& c, int l) {
    const int rows = (l == 0) ? MT : TL;
    const char* X1 = (const char*)c.XA(); const char* OS = (const char*)(c.ws + WS_OS);
    const int* tslot = (const int*)(c.ws + WS_TSLOT); const float* gate = (const float*)(c.ws + WS_GATE);
    const int lane = c.lane;
    for (int r = c.bid * 8 + c.wave; r < rows; r += c.nb * 8) {
        const int4 sl = *(const int4*)(tslot + (size_t)r * 4); const float4 gt = *(const float4*)(gate + (size_t)r * 4);
        const char* m = (const char*)(c.mod() + (size_t)(l * 9 + mod_row(r)) * MODW + 5 * D);
        u32x4_t xv[4]; uint2 oa[4], ob[4], oc[4], od[4]; f32x4 g2a[4], g2b[4];
#pragma unroll
        for (int j = 0; j < 4; ++j) { const unsigned col = (unsigned)(j * 64 + lane) * 8u;
            xv[j] = *(const u32x4_t*)(X1 + ((unsigned)r * D + col) * 2u);
            oa[j] = *(const uint2*)(OS + ((unsigned)sl.x * D + col)); ob[j] = *(const uint2*)(OS + ((unsigned)sl.y * D + col)); oc[j] = *(const uint2*)(OS + ((unsigned)sl.z * D + col)); od[j] = *(const uint2*)(OS + ((unsigned)sl.w * D + col));
            g2a[j] = *(const f32x4*)(m + col * 4u); g2b[j] = *(const f32x4*)(m + col * 4u + 16u); }
        float v[4][8]; float ss = 0.f;
#pragma unroll
        for (int j = 0; j < 4; ++j) { float x1[8], fa[8], fb[8], fc[8], fd[8]; unpack8(xv[j], x1); unpack8_fp8(oa[j], fa); unpack8_fp8(ob[j], fb); unpack8_fp8(oc[j], fc); unpack8_fp8(od[j], fd);
#pragma unroll
            for (int i = 0; i < 8; ++i) { const float f = gt.x * fa[i] + gt.y * fb[i] + gt.z * fc[i] + gt.w * fd[i]; const float g2 = i < 4 ? g2a[j][i] : g2b[j][i - 4]; v[j][i] = x1[i] + g2 * f; ss += v[j][i] * v[j][i]; } }
        const float rstd = rsqrtf(wave_sum(ss) * (1.f / D) + EPS);
        if (l == 0) {
            const char* m1 = (const char*)(c.mod() + (size_t)(9 + mod_row(r)) * MODW); const char* g1n = (const char*)(c.I(I_N1G) + D);
#pragma unroll
            for (int jh = 0; jh < 2; ++jh) {
                f32x4 gg[2][2], sc[2][2], sh[2][2];
#pragma unroll
                for (int j2 = 0; j2 < 2; ++j2)
#pragma unroll
                    for (int q = 0; q < 2; ++q) { const unsigned co = ((unsigned)((jh * 2 + j2) * 64 + lane) * 8u + 4u * q) * 4u; gg[j2][q] = *(const f32x4*)(g1n + co); sc[j2][q] = *(const f32x4*)(m1 + (unsigned)(D * 4) + co); sh[j2][q] = *(const f32x4*)(m1 + co); }
#pragma unroll
                for (int j2 = 0; j2 < 2; ++j2) { const int j = jh * 2 + j2; const unsigned col = (unsigned)(j * 64 + lane) * 8u;
                    *(uint4*)((char*)c.XB() + ((unsigned)r * D + col) * 2u) = make_uint4(pk2(v[j][0], v[j][1]), pk2(v[j][2], v[j][3]), pk2(v[j][4], v[j][5]), pk2(v[j][6], v[j][7]));
                    float h[8];
#pragma unroll
                    for (int i = 0; i < 8; ++i) h[i] = v[j][i] * rstd * gg[j2][i >> 2][i & 3] * (1.f + sc[j2][i >> 2][i & 3]) + sh[j2][i >> 2][i & 3];
                    *(uint4*)((char*)c.H() + ((unsigned)r * D + col) * 2u) = make_uint4(pk2(h[0], h[1]), pk2(h[2], h[3]), pk2(h[4], h[5]), pk2(h[6], h[7])); }
                asm volatile("" ::: "memory");
            }
        } else {
            const char* fgp = (const char*)c.I(I_FG); f32x4 fg[4][2];
#pragma unroll
            for (int j = 0; j < 4; ++j)
#pragma unroll
                for (int q = 0; q < 2; ++q) fg[j][q] = *(const f32x4*)(fgp + ((unsigned)(j * 64 + lane) * 8u + 4u * q) * 4u);
#pragma unroll
            for (int j = 0; j < 4; ++j) { const unsigned col = (unsigned)(j * 64 + lane) * 8u; f32x4 o0, o1;
#pragma unroll
                for (int i = 0; i < 4; ++i) { o0[i] = v[j][i] * rstd * fg[j][0][i]; o1[i] = v[j][4 + i] * rstd * fg[j][1][i]; }
                *(f32x4*)((char*)c.out + ((unsigned)r * D + col) * 4u) = o0; *(f32x4*)((char*)c.out + (((unsigned)r * D + col) * 4u + 16u)) = o1; }
        }
    }
}

constexpr int PH_PER_LAYER = 10, N_PHASES = 2 + 2 * PH_PER_LAYER;
#ifndef REP_0
#define REP_0 1
#endif
#ifndef REP_1
#define REP_1 1
#endif
#ifndef REP_2
#define REP_2 1
#endif
#ifndef REP_3
#define REP_3 1
#endif
#ifndef REP_4
#define REP_4 1
#endif
#ifndef REP_7
#define REP_7 1
#endif
#ifndef REP_8
#define REP_8 1
#endif
#ifndef REP_9
#define REP_9 1
#endif
#ifndef PROBE_CVT
#define PROBE_CVT 1
#endif
#ifndef MK_N_LAUNCHES
#define MK_N_LAUNCHES 1
#endif
__global__ void __launch_bounds__(512, 2) mk_fwd(Params p) {
    extern __shared__ __attribute__((aligned(16))) unsigned char lds[];
    Ctx c; c.in = p.in; c.out = p.out; c.ws = p.ws; c.tid = threadIdx.x; c.lane = c.tid & 63; c.wave = __builtin_amdgcn_readfirstlane(c.tid >> 6); c.bid = blockIdx.x; c.nb = gridDim.x; c.flag = p.pad; c.lds = (LAS unsigned char*)lds;
    const int lo = p.ph_lo, hi = p.ph_hi;
    XcdBarrier bar;
    {
        unsigned* bw = c.ctl() + CW_BAR + p.li * XCD_BAR_WORDS;
        if (c.tid == 0) { *(volatile LAS unsigned*)(c.lds + LDS_XB) = 0u; *(volatile LAS unsigned*)(c.lds + LDS_XB + 4) = 0u; }
        __syncthreads();
        bar = xcd_barrier_post(bw, (volatile LAS unsigned*)(c.lds + LDS_XB));
        if (c.tid == 0 && hi - lo > 1) { unsigned nloc, nx; xcd_barrier_complete(bw, bar.x, nloc, nx); bar.st[0] = nloc; bar.st[1] = nx; }
        __syncthreads();
    }
#define FRESH() do { unsigned _z = 0u; asm volatile("" : "+v"(_z)); c.lane = (int)__builtin_amdgcn_mbcnt_hi(~0u, __builtin_amdgcn_mbcnt_lo(~0u, _z)); asm volatile("" : "+s"(c.bid)); asm volatile("" : "+s"(c.wave)); c.tid = c.wave * 64 + c.lane; } while (0)
#define FRESHL() do { FRESH(); asm volatile("" : "+s"(l)); } while (0)
#ifdef ONLYPH
#define IN(k) ((k) == ONLYPH)
#define INL(i) ((i) + 2 == ONLYPH)
#else
#define IN(k) (lo <= (k) && (k) < hi)
#define INL(i) IN(pb + (i))
#endif
#ifdef TPROBE
#define TSTAMP(k) do { if (c.wave == 0 && __builtin_amdgcn_mbcnt_hi(~0u, __builtin_amdgcn_mbcnt_lo(~0u, 0u)) == 0u) __hip_atomic_store(c.ctl() + CW_TS + (k) * 256 + c.bid, (unsigned)__builtin_amdgcn_s_memrealtime(), __ATOMIC_RELAXED, __HIP_MEMORY_SCOPE_AGENT); } while (0)
#else
#define TSTAMP(k) do { } while (0)
#endif
#define SEAM(k) do { TSTAMP(k); if ((k) + 1 < hi) xcd_barrier<false>(bar, c.wave); } while (0)
#define SEAM0() SEAM(0)
    TSTAMP(1);
    if (IN(0)) { FRESH(); ph_mod_full(c); FRESH(); ph_convert_lru(c); FRESH(); ph_convert_router(c); for (int rep = 0; rep < PROBE_CVT; ++rep) { FRESH(); ph_convert(c); } SEAM0(); }
    for (int l0 = 0; l0 < 2; ++l0) {
        int l = l0;
        const int pb = 2 + l0 * PH_PER_LAYER;
        if (INL(0) && l == 0) { for (int rep = 0; rep < REP_0; ++rep) { FRESHL(); ph_norm1(c, l); } SEAM(pb + 0); }
        if (INL(1)) {
            if (c.nb != 256 || c.bid < (l == 0 ? G_IN0 : G_IN1)) { for (int rep = 0; rep < REP_1; ++rep) { FRESHL(); ph_gemm_in(c, l); } }
            else { FRESHL(); if (l == 0) tail_convert(c, CVT_A + (c.bid - G_IN0) * Q_IN0, Q_IN0); else tail_convert(c, CVT_C + (c.bid - G_IN1) * Q_IN1, Q_IN1); }
            SEAM(pb + 1); }
#define DEAL(n_, off_) for (int it = (int)((unsigned)(c.bid + c.nb * 64 - (off_)) % (unsigned)c.nb); it < (n_); it += c.nb)
#define DEAL_FROM(n_, first_) for (int it = c.bid - (first_); it >= 0 && it < (n_); it += c.nb - (first_))
        if (INL(2)) {
            const int nLru = NB * NCHUNK, nA = (l == 0) ? MT / 32 : TL / 32;
            for (int rep = 0; rep < REP_2; ++rep) {
            FRESHL();
            DEAL(nLru, 0) lru::lru_item<0>(c, l, it / NCHUNK, it % NCHUNK);
            FRESHL();
            DEAL_FROM(nA, nLru % c.nb) conva_item(c, l, it);
            }
            SEAM(pb + 2);
        }
        if (INL(3)) {
            const int nAtt = NB * 4 * (SEQ / 256) + (l == 0 ? NB * 4 : 0), nLru = (l == 0) ? NB * NCHUNK : NB * (NCHUNK - NCC), nA = (l == 0) ? MT / 32 : TL / 32;
            for (int rep = 0; rep < REP_3; ++rep) { FRESHL(); ph_attention(c, l); }
            FRESHL();
            DEAL(nLru, nAtt) { const int per = (l == 0) ? NCHUNK : NCHUNK - NCC; lru::lru_item<1>(c, l, it / per, (l == 0 ? 0 : NCC) + it % per); }
            FRESHL();
            DEAL_FROM(nA, (l == 0) ? 64 : 0) convc_item(c, l, it);
            if (l == 0 && c.nb == 256 && c.bid >= MIX_FIRST) { FRESHL(); tail_convert(c, CVT_M + (c.bid - MIX_FIRST) * Q_MIX, Q_MIX); }
            SEAM(pb + 3);
        }
#undef DEAL
        if (INL(4)) {
            if (c.nb != 256 || l != 0 || c.bid < G_OUT0) { for (int rep = 0; rep < REP_4; ++rep) { FRESHL(); ph_gemm_out(c, l); } }
            else { FRESHL(); tail_convert(c, CVT_B + (c.bid - G_OUT0) * Q_OUT0, Q_OUT0); }
            SEAM(pb + 4); }
        if (INL(5)) { FRESHL(); ph_norm2_router(c, l); SEAM(pb + 5); }
        if (INL(6)) { FRESHL(); ph_slots(c, l); SEAM(pb + 6); }
        if (INL(7)) { for (int rep = 0; rep < REP_7; ++rep) { FRESHL(); ph_moe1(c, l); } SEAM(pb + 7); }
        if (INL(8)) { for (int rep = 0; rep < REP_8; ++rep) { FRESHL(); ph_moe2(c, l); } SEAM(pb + 8); }
        if (INL(9)) { for (int rep = 0; rep < REP_9; ++rep) { FRESHL(); ph_combine(c, l); } SEAM(pb + 9); }
    }
#ifdef TPROBE
    if (c.bid == 0 && c.wave == 0 && __builtin_amdgcn_mbcnt_hi(~0u, __builtin_amdgcn_mbcnt_lo(~0u, 0u)) == 0u) {
        unsigned* ts = c.ctl() + CW_TS;
        const unsigned t0 = xb_ld(ts + TP_K * 256);
        int mA = -(1 << 30), mB = -(1 << 30), mP = -(1 << 30);
        for (int b = 0; b < (int)c.nb; ++b) { const int d = (int)(xb_ld(ts + TP_K * 256 + b) - t0); if (b < TP_G) mA = d > mA ? d : mA; else mB = d > mB ? d : mB;
            const int dp = (int)(xb_ld(ts + TP_KP * 256 + b) - t0); mP = dp > mP ? dp : mP; }
        const int mAll = mA > mB ? mA : mB;
        int stat = 0;
        if (TP_MODE == 1) stat = mAll - mP;
        if (TP_MODE == 2) stat = mA - mB;
        if (TP_MODE == 3) stat = mB - mA;
        if (TP_MODE == 4) stat = mB - mA + TP_OFF;
        if (stat < 0) stat = 0;
        const unsigned long long tend = __builtin_amdgcn_s_memrealtime() + (unsigned long long)stat * TP_AMP;
        while (__builtin_amdgcn_s_memrealtime() < tend) __builtin_amdgcn_s_sleep(8);
    }
#endif
#undef IN
#undef INL
#undef SEAM
#undef SEAM0
#undef FRESH
#undef FRESHL
}

extern "C" void kernel_launch(void* const* d_in, const int* in_sizes, int n_in, void* d_out, int out_size, void* d_ws, size_t ws_size, hipStream_t stream) {
    static int grid = 0;
    if (grid == 0) {
        if (n_in != N_INPUTS || out_size != TL * D || ws_size < WS_END) { fprintf(stderr, "kernel_launch: unexpected shapes (n_in %d, out %d, ws %zu)\n", n_in, out_size, ws_size); grid = -1; return; }
        int dev = 0, cus = 0, per_cu = 0;
        if (hipGetDevice(&dev) != hipSuccess || hipDeviceGetAttribute(&cus, hipDeviceAttributeMultiprocessorCount, dev) != hipSuccess) { grid = -1; return; }
        if (hipFuncSetAttribute((const void*)mk_fwd, hipFuncAttributeMaxDynamicSharedMemorySize, LDS_BYTES) != hipSuccess) { fprintf(stderr, "kernel_launch: hipFuncSetAttribute failed\n"); grid = -1; return; }
        if (hipOccupancyMaxActiveBlocksPerMultiprocessor(&per_cu, (const void*)mk_fwd, 512, LDS_BYTES) != hipSuccess || per_cu < 1) { fprintf(stderr, "kernel_launch: occupancy query says %d workgroups per CU\n", per_cu); grid = -1; return; }
        grid = cus < 256 ? cus : 256;
    }
    if (grid < 0) return;
    (void)hipMemsetAsync((char*)d_ws + WS_CTL, 0, CTL_BYTES, stream);
    Params p{};
    for (int i = 0; i < N_INPUTS; ++i) p.in[i] = (const float*)d_in[i];
    p.out = (float*)d_out; p.ws = (unsigned char*)d_ws;
#ifdef PROBE_PHASE
    const int cuts[4] = {0, PROBE_PHASE + 1, PROBE_PHASE + 1, N_PHASES};
    for (int li = 0; li < 3; ++li) { p.ph_lo = (li == 1) ? PROBE_PHASE : cuts[li]; p.ph_hi = cuts[li + 1]; p.li = li; p.pad = (li == 1); if (li == 2) p.ph_lo = PROBE_PHASE + 1; if (p.ph_lo < p.ph_hi) hipLaunchKernelGGL(mk_fwd, dim3(grid), dim3(512), LDS_BYTES, stream, p); }
#else
    p.ph_lo = 0; p.ph_hi = N_PHASES; p.li = 0;
    hipLaunchKernelGGL(mk_fwd, dim3(grid), dim3(512), LDS_BYTES, stream, p);
#endif
}
```

```cpp
#include <hip/hip_runtime.h>
#include <cstdio>

typedef unsigned short bf16_t;
#define LAS __attribute__((address_space(3)))
typedef LAS float lfloat;
typedef float f32x4 __attribute__((ext_vector_type(4)));
typedef LAS f32x4 lf32x4;
__device__ __forceinline__ float4 lds_ld4(const lfloat* p) { const f32x4 v = *(const lf32x4*)p; return make_float4(v.x, v.y, v.z, v.w); }
__device__ __forceinline__ void lds_st4(lfloat* p, float4 v) { *(lf32x4*)p = (f32x4){v.x, v.y, v.z, v.w}; }
typedef LAS int lint;

constexpr int D = 2048, NB = 8, SEQ = 2048, CTXL = 256;
constexpr int TL = NB * SEQ;
constexpr int TC = NB * CTXL;
constexpr int MT = TL + TC;
constexpr int NIN = 5120, GW = 512, NE = 32, DFF = 1024;
constexpr int MODW = 6 * D;
constexpr int NSLOT = 81920;
constexpr float EPS = 1e-6f;
constexpr int NKC = 16;
constexpr int NCHUNK = 36, NCC = 4;

enum { I_X = 0, I_C, I_CTX, I_CCTX, I_ADAW, I_ADAB, I_N1G, I_N2G, I_WIN, I_WOUT, I_CAW, I_CAB, I_LNAG, I_LNAB, I_DLAM, I_DNG, I_CCW, I_NCG,
       I_LCW, I_LCB, I_LWA, I_LBA, I_LWX, I_LBX, I_LLAM, I_NDG, I_RW, I_RB, I_W1, I_B1, I_W2, I_B2, I_FG, N_INPUTS };

constexpr size_t MiB = 1ull << 20;
constexpr size_t WS_CTL = 0, CTL_BYTES = 1 * MiB;
constexpr size_t WS_MODP = 1 * MiB;
constexpr size_t WS_MOD = 17 * MiB;
constexpr size_t WS_H = 18 * MiB;
constexpr size_t WS_U = 90 * MiB;
constexpr size_t WS_YM = 270 * MiB;
constexpr size_t WS_XA = 342 * MiB;
constexpr size_t WS_XB = 486 * MiB;
constexpr size_t WS_SP = 630 * MiB;
constexpr size_t WS_TOPI = 636 * MiB;
constexpr size_t WS_GATE = 637 * MiB;
constexpr size_t WS_TSLOT = 638 * MiB;
constexpr size_t WS_STOK = 639 * MiB;
constexpr size_t WS_ACT = 640 * MiB;
constexpr size_t WS_OS = 800 * MiB;
constexpr size_t WS_WIN = 1120 * MiB;
constexpr size_t WS_WOUT = 1160 * MiB;
constexpr size_t WS_W1T = 1176 * MiB;
constexpr size_t WS_W2T = 1688 * MiB;
constexpr size_t WS_OST = 1944 * MiB;
constexpr size_t WS_RWF = 2013 * MiB;
constexpr size_t WS_H8 = 1977 * MiB;
constexpr size_t WS_WG = 1976 * MiB;
constexpr size_t WS_END = 2014 * MiB;
constexpr int CW_CNT = 16384;
constexpr int CW_TS = 65536;
constexpr int CW_FILL = 16384 + 4096;
constexpr int CW_BAR = 4096;

constexpr int LDS_BYTES = 147456;
constexpr int LDS_MISC = 131072;
constexpr int LDS_IDX = LDS_MISC + 8192;
constexpr int LDS_XB = LDS_BYTES - 16;

struct Params { const float* in[N_INPUTS]; float* out; unsigned char* ws; int ph_lo, ph_hi, li, pad; };

__device__ __forceinline__ float bf2f(bf16_t h) { return __uint_as_float(((unsigned)h) << 16); }
__device__ __forceinline__ unsigned f2bf(float f) { unsigned u = __float_as_uint(f); return (u + 0x7fffu + ((u >> 16) & 1u)) >> 16; }
__device__ __forceinline__ unsigned pk2(float lo, float hi) { return f2bf(lo) | (f2bf(hi) << 16); }
__device__ __forceinline__ unsigned pk4_fp8(float a, float b, float c2, float d) {
    a = fminf(fmaxf(a, -448.f), 448.f); b = fminf(fmaxf(b, -448.f), 448.f); c2 = fminf(fmaxf(c2, -448.f), 448.f); d = fminf(fmaxf(d, -448.f), 448.f);
    int w = 0; w = __builtin_amdgcn_cvt_pk_fp8_f32(a, b, w, false); w = __builtin_amdgcn_cvt_pk_fp8_f32(c2, d, w, true); return (unsigned)w;
}
constexpr float W8S = 32.f;
__device__ __forceinline__ float sigmoidf_(float x) { return __builtin_amdgcn_rcpf(1.f + __expf(-x)); }
__device__ __forceinline__ float wave_sum(float v) {
#pragma unroll
    for (int o = 1; o < 64; o <<= 1) v += __shfl_xor(v, o);
    return v;
}
__device__ __forceinline__ float wave_max(float v) {
#pragma unroll
    for (int o = 1; o < 64; o <<= 1) v = fmaxf(v, __shfl_xor(v, o));
    return v;
}
template <int R> __device__ __forceinline__ void block_rowsum(float (&v)[R], lfloat* red, int wave, int lane) {
#pragma unroll
    for (int r = 0; r < R; ++r) { const float s = wave_sum(v[r]); if (lane == 0) red[wave * R + r] = s; }
    __syncthreads();
#pragma unroll
    for (int r = 0; r < R; ++r) { float s = 0.f;
#pragma unroll
        for (int w = 0; w < 8; ++w) s += red[w * R + r];
        v[r] = s; }
    __syncthreads();
}


#define XB_TMO      128
#define XB_XCNT(j)  (256  + 64 * (j))
#define XB_XSUB(j)  (1280 + 64 * (j))
#define XB_XGEN(j)  (2304 + 64 * (j))
#define XB_TOP      3328
#define XB_TOPGEN   3392
#define XCD_BAR_WORDS 3456
#define XB_SPIN_CAP (1u << 18)
__device__ __forceinline__ unsigned xb_ld(unsigned* p)              { return __hip_atomic_load(p, __ATOMIC_RELAXED, __HIP_MEMORY_SCOPE_AGENT); }
__device__ __forceinline__ unsigned xb_add(unsigned* p, unsigned v) { return __hip_atomic_fetch_add(p, v, __ATOMIC_RELAXED, __HIP_MEMORY_SCOPE_AGENT); }
__device__ __forceinline__ unsigned xb_xcc_id() { return (unsigned)__builtin_amdgcn_s_getreg((3 << 11) | 20) & 0xFu; }
#define XB_SPIN(cond, bar) do { unsigned _sp = 0; while (cond) { __builtin_amdgcn_s_sleep(1); \
    if ((++_sp & 255u) == 0u) { if (xb_ld(&(bar)[XB_TMO])) break; if (_sp > XB_SPIN_CAP) { atomicAdd(&(bar)[XB_TMO], 1u); break; } } } } while (0)
struct XcdBarrier { unsigned* bar; unsigned x; volatile LAS unsigned* st; };
__device__ __forceinline__ XcdBarrier xcd_barrier_post(unsigned* bar, volatile LAS unsigned* st) {
    XcdBarrier b; b.bar = bar; b.x = xb_xcc_id(); b.st = st;
    if (threadIdx.x == 0) (void)xb_add(&bar[XB_XCNT(b.x)], 1u);
    return b;
}
__device__ __forceinline__ void xcd_barrier_complete(unsigned* bar, unsigned x, unsigned& nloc, unsigned& nx) {
    const unsigned G = gridDim.x * gridDim.y * gridDim.z;
    unsigned sum, cnt, mine, sp = 0u;
    for (;;) {
        sum = 0u; cnt = 0u; mine = 0u;
#pragma unroll
        for (unsigned j = 0; j < 16; ++j) { const unsigned c = xb_ld(&bar[XB_XCNT(j)]); sum += c; cnt += (c > 0u) ? 1u : 0u; mine = (j == x) ? c : mine; }
        if (sum == G) break;
        __builtin_amdgcn_s_sleep(1);
        if ((++sp & 255u) == 0u) { if (xb_ld(&bar[XB_TMO])) break; if (sp > XB_SPIN_CAP) { atomicAdd(&bar[XB_TMO], 1u); break; } }
    }
    nloc = mine > 0u ? mine : 1u; nx = cnt > 0u ? cnt : 1u;
}
template <bool FIRST> __device__ __forceinline__ void xcd_barrier(const XcdBarrier& b, int wave_id) {
    asm volatile("s_waitcnt vmcnt(0)" ::: "memory");
    __syncthreads();
    if (wave_id == 0 && __builtin_amdgcn_mbcnt_hi(~0u, __builtin_amdgcn_mbcnt_lo(~0u, 0u)) == 0u) {
        unsigned* bar = b.bar;
        __builtin_amdgcn_s_waitcnt(0);
        unsigned nloc = b.st[0], nx = b.st[1];
        if constexpr (FIRST) { if (nloc == 0u) { xcd_barrier_complete(bar, b.x, nloc, nx); b.st[0] = nloc; b.st[1] = nx; } }
        const unsigned old = xb_add(&bar[XB_XSUB(b.x)], 1u);
        const unsigned gen = old / nloc;
        if (old + 1u == (gen + 1u) * nloc) {
            __builtin_amdgcn_fence(__ATOMIC_RELEASE, "agent");
            asm volatile("s_waitcnt vmcnt(0)" ::: "memory");
            const unsigned og = xb_add(&bar[XB_TOP], 1u);
            const unsigned tg = og / nx;
            if (og + 1u == (tg + 1u) * nx) xb_add(&bar[XB_TOPGEN], 1u);
            else XB_SPIN(xb_ld(&bar[XB_TOPGEN]) == tg, bar);
            __builtin_amdgcn_fence(__ATOMIC_ACQUIRE, "agent");
            xb_add(&bar[XB_XGEN(b.x)], 1u);
            asm volatile("s_waitcnt vmcnt(0)" ::: "memory");
        } else {
            XB_SPIN(xb_ld(&bar[XB_XGEN(b.x)]) == gen, bar);
            __builtin_amdgcn_fence(__ATOMIC_ACQUIRE, "agent");
            asm volatile("s_waitcnt vmcnt(0)" ::: "memory");
        }
    }
    __syncthreads();
}

struct Ctx {
    const float* const* in; float* out; unsigned char* ws;
    int tid, lane, wave, bid, nb, flag;
    LAS unsigned char* lds;
    __device__ __forceinline__ const float* I(int i) const { asm volatile("" : "+s"(i)); return in[i]; }
    __device__ __forceinline__ float* mod() const { return (float*)(ws + WS_MOD); }
    __device__ __forceinline__ bf16_t* H() const { return (bf16_t*)(ws + WS_H); }
    __device__ __forceinline__ bf16_t* U() const { return (bf16_t*)(ws + WS_U); }
    __device__ __forceinline__ bf16_t* YM() const { return (bf16_t*)(ws + WS_YM); }
    __device__ __forceinline__ bf16_t* XA() const { return (bf16_t*)(ws + WS_XA); }
    __device__ __forceinline__ bf16_t* XB() const { return (bf16_t*)(ws + WS_XB); }
    __device__ __forceinline__ unsigned* ctl() const { return (unsigned*)(ws + WS_CTL); }
};


namespace pg8 {
typedef short bf16x8 __attribute__((ext_vector_type(8)));
typedef float f32x4 __attribute__((ext_vector_type(4)));
typedef unsigned u32x4 __attribute__((ext_vector_type(4)));
typedef unsigned u32x2 __attribute__((ext_vector_type(2)));
constexpr int BM = 256, BK = 64, HALF = 128, HTB = HALF * BK * 2, STAGE_BYTES = 8 * HTB;
__device__ __forceinline__ int lds_byte(int r, int c) { const int st = (r >> 4) * 2 + (c >> 5), rr = r & 15, cc = c & 31, ob = rr * 64 + cc * 2; return st * 1024 + (ob ^ (((ob >> 9) & 1) << 5)); }
__device__ __forceinline__ void stage_rc(int b, int& R, int& C) { const int st = b / 1024, sb = b % 1024, swz = sb ^ (((sb >> 9) & 1) << 5); R = (st >> 1) * 16 + swz / 64; C = (st & 1) * 32 + (swz % 64) / 2; }
__device__ __forceinline__ int perm32(int rho) { const int n = rho >> 4, i = rho & 15; return 8 * (i >> 2) + 4 * n + (i & 3); }
__device__ __forceinline__ unsigned cvt_pk_bf16(float lo, float hi) { unsigned r; asm volatile("v_cvt_pk_bf16_f32 %0, %1, %2" : "=v"(r) : "v"(lo), "v"(hi)); return r; }
__device__ __forceinline__ int fresh_lane() { unsigned z = 0u; asm volatile("" : "+v"(z)); return (int)__builtin_amdgcn_mbcnt_hi(~0u, __builtin_amdgcn_mbcnt_lo(~0u, z)); }
struct Unit { int row0, col0, e; };
__device__ __forceinline__ void tile_order(int L, int nM, int nN, int& pm, int& pn) {
    const int nwg = nM * nN; int wgid = L; { const int q = nwg / 8, r = nwg % 8, xcd = wgid % 8, off = wgid / 8; wgid = (xcd < r ? xcd * (q + 1) : r * (q + 1) + (xcd - r) * q) + off; }
    const int nig = 8 * nN, gid = wgid / nig, fm = gid * 8, gsz = (nM - fm) < 8 ? (nM - fm) : 8;
    pm = fm + ((wgid % nig) % gsz); pn = (wgid % nig) / gsz;
}
template <int KB  , bool GATHER, bool FP8  , class Epi, class Sched>
__device__ __forceinline__ void gemm_phase(LAS unsigned char* lds, LAS unsigned char* idxslot, const Sched& S, const Epi& E, int tid) {
    const int wid = __builtin_amdgcn_readfirstlane(tid >> 6), lane = tid & 63, wr = wid >> 2, wc = wid & 3, fr = lane & 15, fq = lane >> 4;
    constexpr int nt = KB / 128;
    static_assert(nt >= 4 && nt % 2 == 0, "K-tile count");
    typedef int i32x4 __attribute__((ext_vector_type(4)));
    typedef int i32x8 __attribute__((ext_vector_type(8)));
    unsigned vo[2][2], voffB[2];
#pragma unroll
    for (int i = 0; i < 2; ++i) { int R, C; stage_rc(tid * 16 + i * 8192, R, C); const int Rb = Epi::PERM ? ((R & ~31) + perm32(R & 31)) : R;
        vo[0][i] = (unsigned)(R * KB + C * 2); vo[1][i] = (unsigned)((R + HALF) * KB + C * 2); voffB[i] = (unsigned)(Rb * KB + C * 2); }
    constexpr size_t kstep = 128, hstep = (size_t)HALF * KB;
    const unsigned ldsb = (unsigned)__builtin_amdgcn_readfirstlane((int)(unsigned)(size_t)lds + wid * 1024);
    const int aoff = lds_byte(wr * 64 + fr, fq * 8), boff = lds_byte(wc * 32 + fr, fq * 8);
#define PG8_SA(b, h) (((b) * 2 + (h)) * HTB)
#define PG8_SB(b, h) ((4 + (b) * 2 + (h)) * HTB)
#define PG8_GLDS(sbase, voff32, ldsdst) do { unsigned _keep; asm volatile("s_mov_b32 %0, m0\n\ts_mov_b32 m0, %3\n\ts_nop 0\n\tglobal_load_lds_dwordx4 %1, %2\n\ts_mov_b32 m0, %0" \
        : "=&s"(_keep) : "v"(voff32), "s"(sbase), "s"(ldsdst) : "memory"); } while (0)
#define PG8_STAGEB(bufoff, gbase) do { _Pragma("unroll") for (int _i = 0; _i < 2; ++_i) PG8_GLDS((const char*)(gbase), voffB[_i], ldsb + (unsigned)((bufoff) + _i * 8192)); } while (0)
#define PG8_STAGEA(bufoff, gbase, V, h) do { _Pragma("unroll") for (int _i = 0; _i < 2; ++_i) PG8_GLDS((const char*)(gbase) + (GATHER ? 0 : (h) * hstep), (V)[GATHER ? (h) : 0][_i], ldsb + (unsigned)((bufoff) + _i * 8192)); } while (0)
#define PG8_LDA(dst, b, h) do { _Pragma("unroll") for (int m = 0; m < 4; ++m) { const i32x4 _lo = *(const LAS i32x4*)(lds + PG8_SA(b, h) + aoff + m * 2048), _hi = *(const LAS i32x4*)(lds + PG8_SA(b, h) + aoff + m * 2048 + 1024); \
        dst[m] = __builtin_shufflevector(_lo, _hi, 0, 1, 2, 3, 4, 5, 6, 7); } } while (0)
#define PG8_LDB(dst, b, h) do { _Pragma("unroll") for (int n = 0; n < 2; ++n) { const i32x4 _lo = *(const LAS i32x4*)(lds + PG8_SB(b, h) + boff + n * 2048), _hi = *(const LAS i32x4*)(lds + PG8_SB(b, h) + boff + n * 2048 + 1024); \
        dst[n] = __builtin_shufflevector(_lo, _hi, 0, 1, 2, 3, 4, 5, 6, 7); } } while (0)
#define PG8_MMA(ai, bj, At, Bt) do { __builtin_amdgcn_s_setprio(1); _Pragma("unroll") for (int m = 0; m < 4; ++m) _Pragma("unroll") for (int n = 0; n < 2; ++n) { \
        if constexpr (FP8) acc[ai][bj][m][n] = __builtin_amdgcn_mfma_scale_f32_16x16x128_f8f6f4(Bt[n], At[m], acc[ai][bj][m][n], 0, 0, 0, 0x7f7f7f7f, 0, 0x7f7f7f7f); \
        else { acc[ai][bj][m][n] = __builtin_amdgcn_mfma_f32_16x16x32_bf16(__builtin_bit_cast(bf16x8, __builtin_shufflevector(Bt[n], Bt[n], 0, 1, 2, 3)), __builtin_bit_cast(bf16x8, __builtin_shufflevector(At[m], At[m], 0, 1, 2, 3)), acc[ai][bj][m][n], 0, 0, 0); \
               acc[ai][bj][m][n] = __builtin_amdgcn_mfma_f32_16x16x32_bf16(__builtin_bit_cast(bf16x8, __builtin_shufflevector(Bt[n], Bt[n], 4, 5, 6, 7)), __builtin_bit_cast(bf16x8, __builtin_shufflevector(At[m], At[m], 4, 5, 6, 7)), acc[ai][bj][m][n], 0, 0, 0); } } \
        __builtin_amdgcn_s_setprio(0); } while (0)
#define PG8_WAIT_V(n) asm volatile("s_waitcnt vmcnt(" #n ")" ::: "memory")
#define PG8_WAIT_L(n) asm volatile("s_waitcnt lgkmcnt(" #n ")" ::: "memory")
#define PG8_BAR __builtin_amdgcn_s_barrier()
#define PG8_SCHED __builtin_amdgcn_sched_barrier(0)
    Unit cur, nxt; int ui = 0;
    if (!S.next(0, cur)) return;
    f32x4 acc[2][2][4][2];
#pragma unroll
    for (int a = 0; a < 2; ++a)
#pragma unroll
        for (int b = 0; b < 2; ++b)
#pragma unroll
            for (int m = 0; m < 4; ++m)
#pragma unroll
                for (int n = 0; n < 2; ++n) acc[a][b][m][n] = (f32x4){0.f, 0.f, 0.f, 0.f};
    i32x8 At[4], B0[2], B1[2];
    const char* cA = S.a_base(cur); const char* cB = S.b_base(cur);
    if constexpr (GATHER) { const int* ix = S.a_idx(cur);
#pragma unroll
        for (int i = 0; i < 2; ++i) { int R, C; stage_rc(tid * 16 + i * 8192, R, C); vo[0][i] = (unsigned)ix[R] * (unsigned)KB + (unsigned)(C * 2); vo[1][i] = (unsigned)ix[HALF + R] * (unsigned)KB + (unsigned)(C * 2); }
        PG8_WAIT_V(0); }
    PG8_STAGEB(PG8_SB(0, 0), cB); PG8_STAGEB(PG8_SB(0, 1), cB + hstep); PG8_STAGEA(PG8_SA(0, 0), cA, vo, 0); PG8_STAGEA(PG8_SA(0, 1), cA, vo, 1);
    if (wr == 1) PG8_BAR;
    PG8_WAIT_V(2); PG8_BAR;
    PG8_STAGEB(PG8_SB(1, 0), cB + kstep); PG8_STAGEA(PG8_SA(1, 0), cA + kstep, vo, 0); PG8_STAGEB(PG8_SB(1, 1), cB + hstep + kstep);
    PG8_WAIT_V(6); PG8_BAR;
    for (;;) {
        const bool has_next = S.next(ui + 1, nxt);
        const char* nA = has_next ? S.a_base(nxt) : cA; const char* nB = has_next ? S.b_base(nxt) : cB;
        if constexpr (GATHER) { if (has_next && wid < 4) { const int ln = wid * 64 + fresh_lane();
            __builtin_amdgcn_global_load_lds((const unsigned*)(S.a_idx(nxt) + ln), (LAS unsigned*)(idxslot + wid * 256), 4, 0, 0); } }
#pragma unroll 1
        for (int t = 0; t < nt; t += 2) {
            const bool last = (t == nt - 2);
            const char* a1 = cA + (size_t)(t + 1) * kstep;
            const char* a2 = last ? nA : cA + (size_t)(t + 2) * kstep; const char* b2 = last ? nB : cB + (size_t)(t + 2) * kstep;
            const char* a3 = a2 + kstep; const char* b3 = b2 + kstep;
            PG8_LDB(B0, 0, 0); PG8_LDB(B1, 0, 1); PG8_SCHED; PG8_LDA(At, 0, 0); PG8_STAGEA(PG8_SA(1, 1), a1, vo, 1);
            PG8_WAIT_V(8); PG8_WAIT_L(0); PG8_BAR; PG8_MMA(0, 0, At, B0); PG8_MMA(0, 1, At, B1); PG8_BAR; PG8_SCHED;
            if constexpr (GATHER) { if (last && has_next) {
#pragma unroll
                for (int i = 0; i < 2; ++i) { int R, C; stage_rc((wid * 64 + fresh_lane()) * 16 + i * 8192, R, C);
                    vo[0][i] = *(const LAS unsigned*)(idxslot + R * 4) * (unsigned)KB + (unsigned)(C * 2); vo[1][i] = *(const LAS unsigned*)(idxslot + (HALF + R) * 4) * (unsigned)KB + (unsigned)(C * 2); } } }
            PG8_LDA(At, 0, 1); PG8_STAGEB(PG8_SB(0, 0), b2); PG8_STAGEB(PG8_SB(0, 1), b2 + hstep); PG8_STAGEA(PG8_SA(0, 0), a2, vo, 0);
            PG8_WAIT_V(8); PG8_WAIT_L(0); PG8_BAR; PG8_MMA(1, 0, At, B0); PG8_MMA(1, 1, At, B1); PG8_BAR; PG8_SCHED;
            PG8_LDB(B0, 1, 0); PG8_LDB(B1, 1, 1); PG8_SCHED; PG8_LDA(At, 1, 0); PG8_STAGEA(PG8_SA(0, 1), a2, vo, 1);
            PG8_WAIT_V(8); PG8_WAIT_L(0); PG8_BAR; PG8_MMA(0, 0, At, B0); PG8_MMA(0, 1, At, B1); PG8_BAR; PG8_SCHED;
            PG8_LDA(At, 1, 1); PG8_STAGEB(PG8_SB(1, 0), b3); PG8_STAGEB(PG8_SB(1, 1), b3 + hstep); PG8_STAGEA(PG8_SA(1, 0), a3, vo, 0);
            PG8_WAIT_V(8); PG8_WAIT_L(0); PG8_BAR; PG8_MMA(1, 0, At, B0); PG8_MMA(1, 1, At, B1); PG8_BAR; PG8_SCHED;
        }
        if (wr == 0) PG8_BAR;
        { const int l2 = fresh_lane(); E(acc, cur, wr, wc, l2 & 15, l2 >> 4); }
        if (!has_next) break;
#pragma unroll
        for (int a = 0; a < 2; ++a)
#pragma unroll
            for (int b = 0; b < 2; ++b)
#pragma unroll
                for (int m = 0; m < 4; ++m)
#pragma unroll
                    for (int n = 0; n < 2; ++n) acc[a][b][m][n] = (f32x4){0.f, 0.f, 0.f, 0.f};
        cur = nxt; cA = nA; cB = nB; ++ui;
        if (wr == 1) PG8_BAR;
    }
    PG8_WAIT_V(0);
    PG8_BAR;
#undef PG8_SA
#undef PG8_SB
#undef PG8_STAGEA
#undef PG8_GLDS
#undef PG8_STAGEB
#undef PG8_LDA
#undef PG8_LDB
#undef PG8_MMA
#undef PG8_WAIT_V
#undef PG8_WAIT_L
#undef PG8_BAR
#undef PG8_SCHED
}
}

__device__ __forceinline__ const float* xsrc_row(const Ctx& c, int l, int r) {
    return (r < TL) ? c.I(I_X) + (size_t)r * D : c.I(I_CTX) + (size_t)(r - TL) * D;
}
__device__ __forceinline__ int mod_row(int r) { return r < TL ? r / SEQ : 8; }

constexpr int MOD_ITEMS = 2 * (MODW / 128);
__device__ __forceinline__ void ph_mod_full(const Ctx& c) {
    lfloat* sl = (lfloat*)c.lds;
    lfloat* red = (lfloat*)c.lds;
    for (int it = c.bid; it < MOD_ITEMS; it += c.nb) {
        const int l = it / (MODW / 128), col0 = (it % (MODW / 128)) * 128;
        __syncthreads();
        { float cv[36];
          const float* cp = c.I(I_C) + c.tid; const float* xp = c.I(I_CCTX) + c.tid;
#pragma unroll
          for (int j = 0; j < 36; ++j) cv[j] = (j < 32) ? cp[(j >> 2) * D + 512 * (j & 3)] : xp[512 * (j & 3)];
#pragma unroll
          for (int j = 0; j < 36; ++j) sl[(512 * (j & 3) + c.tid) * 12 + (j >> 2)] = cv[j] * sigmoidf_(cv[j]); }
        __syncthreads();
        const int q = c.tid & 31, kg = c.tid >> 5;
        float acc[9][4];
#pragma unroll
        for (int r = 0; r < 9; ++r)
#pragma unroll
            for (int e = 0; e < 4; ++e) acc[r][e] = 0.f;
        const float* wp = c.I(I_ADAW) + ((size_t)l * D + kg) * MODW + col0 + 4 * q;
        const lfloat* sp = sl + kg * 12;
#pragma unroll 16
        for (int i = 0; i < 128; ++i) {
            const f32x4 w = __builtin_nontemporal_load((const f32x4*)(wp + (size_t)(16 * i) * MODW));
            const float4 s0 = lds_ld4(sp + i * 192), s1 = lds_ld4(sp + i * 192 + 4); const float s8 = sp[i * 192 + 8];
            const float sv[9] = {s0.x, s0.y, s0.z, s0.w, s1.x, s1.y, s1.z, s1.w, s8};
#pragma unroll
            for (int r = 0; r < 9; ++r) { acc[r][0] += sv[r] * w.x; acc[r][1] += sv[r] * w.y; acc[r][2] += sv[r] * w.z; acc[r][3] += sv[r] * w.w; }
        }
        __syncthreads();
#pragma unroll
        for (int r = 0; r < 9; ++r) lds_st4(red + (kg * 9 + r) * 128 + 4 * q, make_float4(acc[r][0], acc[r][1], acc[r][2], acc[r][3]));
        __syncthreads();
        for (int o = c.tid; o < 9 * 128; o += 512) { const int r = o >> 7, n = o & 127; float sum = c.I(I_ADAB)[l * MODW + col0 + n];
#pragma unroll
            for (int g = 0; g < 16; ++g) sum += red[(g * 9 + r) * 128 + n];
            c.mod()[(size_t)(l * 9 + r) * MODW + col0 + n] = sum; }
    }
    __syncthreads();
}

__device__ __forceinline__ void transpose_item(const float* W, int K, int N, bf16_t* WT, lfloat* scr, int item, int lane) {
    const int nblk = N / 32, kb = item / nblk, nb = item % nblk, k0 = 64 * kb, n0 = 32 * nb;
    { float tv[32]; const float* wp = W + (size_t)(k0 + (lane >> 5)) * N + n0 + (lane & 31);
#pragma unroll
      for (int i = 0; i < 32; ++i) tv[i] = wp[(size_t)(2 * i) * N];
#pragma unroll
      for (int i = 0; i < 32; ++i) scr[(2 * i + (lane >> 5)) * 33 + (lane & 31)] = tv[i]; }
    asm volatile("s_waitcnt lgkmcnt(0)" ::: "memory");
    const int cc = lane & 7;
#pragma unroll
    for (int j = 0; j < 4; ++j) { const int n = (lane >> 3) + 8 * j; const lfloat* sp = scr + (8 * cc) * 33 + n;
        uint4 o; o.x = pk2(sp[0 * 33], sp[1 * 33]); o.y = pk2(sp[2 * 33], sp[3 * 33]); o.z = pk2(sp[4 * 33], sp[5 * 33]); o.w = pk2(sp[6 * 33], sp[7 * 33]);
        *(uint4*)(WT + (size_t)(n0 + n) * K + k0 + 8 * cc) = o; }
    asm volatile("s_waitcnt lgkmcnt(0)" ::: "memory");
}
__device__ __forceinline__ void transpose_item8(const float* W, int K, int N, unsigned char* WT, lfloat* scr, int item, int lane) {
    const int nblk = N / 32, kb = item / nblk, nb = item % nblk, k0 = 128 * kb, n0 = 32 * nb;
    const float* wp = W + (size_t)(k0 + (lane >> 5)) * N + n0 + (lane & 31);
#pragma unroll
    for (int hf = 0; hf < 2; ++hf) { float tv[32];
#pragma unroll
        for (int i = 0; i < 32; ++i) tv[i] = __builtin_nontemporal_load(wp + (size_t)(64 * hf + 2 * i) * N);
#pragma unroll
        for (int i = 0; i < 32; ++i) scr[(64 * hf + 2 * i + (lane >> 5)) * 33 + (lane & 31)] = tv[i]; }
    asm volatile("s_waitcnt lgkmcnt(0)" ::: "memory");
    const int cc = lane & 7;
#pragma unroll
    for (int j = 0; j < 4; ++j) { const int n = (lane >> 3) + 8 * j; const lfloat* sp = scr + (16 * cc) * 33 + n;
        uint4 o; o.x = pk4_fp8(sp[0 * 33] * W8S, sp[1 * 33] * W8S, sp[2 * 33] * W8S, sp[3 * 33] * W8S); o.y = pk4_fp8(sp[4 * 33] * W8S, sp[5 * 33] * W8S, sp[6 * 33] * W8S, sp[7 * 33] * W8S);
        o.z = pk4_fp8(sp[8 * 33] * W8S, sp[9 * 33] * W8S, sp[10 * 33] * W8S, sp[11 * 33] * W8S); o.w = pk4_fp8(sp[12 * 33] * W8S, sp[13 * 33] * W8S, sp[14 * 33] * W8S, sp[15 * 33] * W8S);
        *(uint4*)(WT + (size_t)(n0 + n) * K + k0 + 16 * cc) = o; }
    asm volatile("s_waitcnt lgkmcnt(0)" ::: "memory");
}
constexpr int CV_E1 = (D / 128) * (D / 32), CV_E2 = (DFF / 128) * (D / 32), CV_LAYER = NE * (CV_E1 + CV_E2), CV_ALL = 2 * CV_LAYER;
__device__ __forceinline__ void expert_item(const Ctx& c, int gidx, lfloat* scr, int lane) {
    const int layer = gidx / CV_LAYER, r = gidx % CV_LAYER;
    if (r < NE * CV_E1) { const int m = layer * NE + r / CV_E1; transpose_item8(c.I(I_W1) + (size_t)m * D * D, D, D, c.ws + WS_W1T + (size_t)m * D * D, scr, r % CV_E1, lane); }
    else { const int r2 = r - NE * CV_E1, m = layer * NE + r2 / CV_E2; transpose_item8(c.I(I_W2) + (size_t)m * DFF * D, DFF, D, c.ws + WS_W2T + (size_t)m * D * DFF, scr, r2 % CV_E2, lane); }
}
constexpr int G_IN0 = 240, G_OUT0 = 192, G_IN1 = 192;
constexpr int Q_IN0 = 608, Q_OUT0 = 400, Q_IN1 = 704, Q_MIX = 64, MIX_FIRST = 64, CV_SKEW = 8;
constexpr int CVT_E = CV_ALL, CVT_C = CVT_E - (256 - G_IN1) * Q_IN1, CVT_B = CVT_C - (256 - G_OUT0) * Q_OUT0, CVT_A = CVT_B - (256 - G_IN0) * Q_IN0, CVT_M = CVT_A - (256 - MIX_FIRST) * Q_MIX;
static_assert(CVT_C >= CV_LAYER && CVT_M >= 0, "gemm_in(1)'s slice holds layer-1 items only; layer 0's items finish before moe1(0)");
static_assert(G_IN0 * 6 >= (MT / 256) * (NIN / 256) && G_OUT0 * 3 >= (MT / 256) * (D / 256) && G_IN1 * 7 >= (TL / 256) * (NIN / 256) + (TC / 256) * 6, "whole rounds");
struct CvItem { const float* src; unsigned char* dst; int K; };
__device__ __forceinline__ CvItem cv_decode(const Ctx& c, int gidx) {
    const int layer = gidx / CV_LAYER, r = gidx % CV_LAYER; const float* W; unsigned char* WT; int K, item;
    if (r < NE * CV_E1) { const int m = layer * NE + r / CV_E1; W = c.I(I_W1) + (size_t)m * D * D; WT = c.ws + WS_W1T + (size_t)m * D * D; K = D; item = r % CV_E1; }
    else { const int r2 = r - NE * CV_E1, m = layer * NE + r2 / CV_E2; W = c.I(I_W2) + (size_t)m * DFF * D; WT = c.ws + WS_W2T + (size_t)m * D * DFF; K = DFF; item = r2 % CV_E2; }
    const int kb = item / (D / 32), nb = item % (D / 32);
    return CvItem{W + (size_t)(128 * kb) * D + 32 * nb, WT + (size_t)(32 * nb) * K + 128 * kb, K};
}
#define CV_LOAD(TV, IT) do { const float* _p = (IT).src + (size_t)(16 * (lane >> 3)) * D + 4 * (lane & 7); _Pragma("unroll") for (int _i = 0; _i < 16; ++_i) TV[_i] = __builtin_nontemporal_load((const f32x4*)(_p + (size_t)_i * D)); } while (0)
__device__ __forceinline__ void cv_process(const f32x4 (&tv)[16], const CvItem& it, int lane) {
    unsigned char* d = it.dst + (size_t)(4 * (lane & 7)) * it.K + 16 * (lane >> 3);
#pragma unroll
    for (int e = 0; e < 4; ++e) { uint4 o;
        o.x = pk4_fp8(tv[0][e] * W8S, tv[1][e] * W8S, tv[2][e] * W8S, tv[3][e] * W8S); o.y = pk4_fp8(tv[4][e] * W8S, tv[5][e] * W8S, tv[6][e] * W8S, tv[7][e] * W8S);
        o.z = pk4_fp8(tv[8][e] * W8S, tv[9][e] * W8S, tv[10][e] * W8S, tv[11][e] * W8S); o.w = pk4_fp8(tv[12][e] * W8S, tv[13][e] * W8S, tv[14][e] * W8S, tv[15][e] * W8S);
        *(uint4*)(d + (size_t)e * it.K) = o; }
}
__device__ __forceinline__ void tail_convert(const Ctx& c, int base, int q) {
    lfloat* scr = (lfloat*)(c.lds + c.wave * 16896);
    const int lane = (int)__builtin_amdgcn_mbcnt_hi(~0u, __builtin_amdgcn_mbcnt_lo(~0u, 0u));
    const int n = q / 8; int g = base + c.wave;
    f32x4 ta[16], tb[16];
    { const CvItem i0 = cv_decode(c, g); CV_LOAD(ta, i0); }
#pragma unroll 1
    for (int j = 0; j < n; j += 2) {
        { int gb = g + 8; asm volatile("" : "+s"(gb)); const CvItem ib = cv_decode(c, gb); CV_LOAD(tb, ib); }
        { int ga = g; asm volatile("" : "+s"(ga)); const CvItem ia = cv_decode(c, ga); cv_process(ta, ia, lane); }
        { int gn = (j + 2 < n) ? g + 16 : g; asm volatile("" : "+s"(gn)); const CvItem in = cv_decode(c, gn); CV_LOAD(ta, in); }
        { int gb = g + 8; asm volatile("" : "+s"(gb)); const CvItem ib = cv_decode(c, gb); cv_process(tb, ib, lane); }
        g += 16;
    }
}
__device__ __forceinline__ void ph_convert(const Ctx& c) {
    lfloat* scr = (lfloat*)(c.lds + c.wave * 16896);
    const int gw = c.bid * 8 + c.wave, NGW = c.nb * 8;
    constexpr int I_IN = (D / 64) * (NIN / 32), I_OUT = (D / 64) * (D / 32);
    constexpr int N_IN = 2 * I_IN, N_OUT = 2 * I_OUT;
    const int N_EX = (c.nb == 256) ? CVT_M : CV_ALL;
    const int nfree = (c.nb > MOD_ITEMS) ? (c.nb - MOD_ITEMS) * 8 : 0, NSK = nfree * CV_SKEW, NTOT = N_IN + N_OUT + N_EX;
    const int fw = (c.bid - MOD_ITEMS) * 8 + c.wave;
    int it = (fw >= 0 && nfree) ? fw : NSK + gw;
    while (it < NTOT) {
        int r = it;
        it = (it < NSK) ? ((it + nfree < NSK) ? it + nfree : NSK + gw) : it + NGW;
        if (r < N_IN) { const int m = r / I_IN; transpose_item(c.I(I_WIN) + (size_t)m * D * NIN, D, NIN, (bf16_t*)(c.ws + WS_WIN) + (size_t)m * NIN * D, scr, r % I_IN, c.lane); continue; } r -= N_IN;
        if (r < N_OUT) { const int m = r / I_OUT; transpose_item(c.I(I_WOUT) + (size_t)m * D * D, D, D, (bf16_t*)(c.ws + WS_WOUT) + (size_t)m * D * D, scr, r % I_OUT, c.lane); continue; } r -= N_OUT;
        expert_item(c, r, scr, c.lane);
    }
}

__device__ __forceinline__ void ph_norm1(const Ctx& c, int l) {
    const float* g = c.I(I_N1G) + l * D;
    for (int r = c.bid * 8 + c.wave; r < MT; r += c.nb * 8) {
        const float4* src = (const float4*)xsrc_row(c, l, r);
        float4 v[8]; float ss = 0.f;
#pragma unroll
        for (int j = 0; j < 8; ++j) { v[j] = src[j * 64 + c.lane]; ss += v[j].x * v[j].x + v[j].y * v[j].y + v[j].z * v[j].z + v[j].w * v[j].w; }
        const float rstd = rsqrtf(wave_sum(ss) * (1.f / D) + EPS);
        const float* m = c.mod() + (size_t)(l * 9 + mod_row(r)) * MODW;
        bf16_t* o = c.H() + (size_t)r * D; bf16_t* xb = c.XB() + (size_t)r * D;
#pragma unroll
        for (int j = 0; j < 8; ++j) {
            const int col = (j * 64 + c.lane) * 4;
            *(uint2*)(xb + col) = make_uint2(pk2(v[j].x, v[j].y), pk2(v[j].z, v[j].w));
            const float4 gg = *(const float4*)(g + col), sc = *(const float4*)(m + 1 * D + col), sh = *(const float4*)(m + 0 * D + col);
            const float o0 = v[j].x * rstd * gg.x * (1.f + sc.x) + sh.x, o1 = v[j].y * rstd * gg.y * (1.f + sc.y) + sh.y;
            const float o2 = v[j].z * rstd * gg.z * (1.f + sc.z) + sh.z, o3 = v[j].w * rstd * gg.w * (1.f + sc.w) + sh.w;
            *(uint2*)(o + col) = make_uint2(pk2(o0, o1), pk2(o2, o3));
        }
    }
}

__device__ __forceinline__ float swiglu_act(float g, float up) {
    g = fminf(g, 7.f); up = fminf(fmaxf(up, -7.f), 7.f);
    return (up + 1.f) * (g * sigmoidf_(1.702f * g));
}
using pg8::f32x4; using pg8::Unit;
struct SchedIn { const char* A; const char* Bt; int l, G, c;
    __device__ __forceinline__ bool next(int i, Unit& u) const {
        const int Ge = (G == 256) ? (l == 0 ? G_IN0 : G_IN1) : G;
        const int L = i * Ge + c, nLat = (TL / 256) * (NIN / 256);
        if (l == 0) { if (L >= (MT / 256) * (NIN / 256)) return false; int pm, pn; pg8::tile_order(L, MT / 256, NIN / 256, pm, pn); u.row0 = pm * 256; u.col0 = pn * 256; u.e = 0; return true; }
        if (L >= nLat + (TC / 256) * 6) return false;
        if (L < nLat) { int pm, pn; pg8::tile_order(L, TL / 256, NIN / 256, pm, pn); u.row0 = pm * 256; u.col0 = pn * 256; u.e = 0; return true; }
        const int r = L - nLat, j = r % 6; u.row0 = TL + (r / 6) * 256; u.col0 = ((j < 4) ? 6 + j : 14 + j) * 256; u.e = 0; return true;
    }
    __device__ __forceinline__ const char* a_base(const Unit& u) const { return A + (size_t)u.row0 * D * 2; }
    __device__ __forceinline__ const int* a_idx(const Unit&) const { return nullptr; }
    __device__ __forceinline__ const char* b_base(const Unit& u) const { return Bt + (size_t)u.col0 * D * 2; }
};
struct EpiU { static constexpr bool PERM = true; bf16_t* U;
    __device__ __forceinline__ void operator()(const f32x4 (&acc)[2][2][4][2], const Unit& u, int wr, int wc, int fr, int fq) const {
        const bool rope = (u.col0 >= 1024 && u.col0 < 2048 && u.row0 < TL);
        float inv[8];
#pragma unroll
        for (int j = 0; j < 8; ++j) inv[j] = exp2f(-(float)(8 * (fq & 1) + j) * (13.287712379549449f / 16.f));
        const bool first = fq < 2; const int ax = wc & 1;
#pragma unroll
        for (int ai = 0; ai < 2; ++ai)
#pragma unroll
            for (int m = 0; m < 4; ++m) {
                const int row = u.row0 + ai * 128 + wr * 64 + m * 16 + fr;
                const unsigned roff = (unsigned)(row * NIN + u.col0 + wc * 32 + 8 * fq) * 2u;
                float cs[8], sn[8];
                if (rope) { const int t = row & (SEQ - 1); const float pp = ax ? (float)(t & 63) : (float)(t >> 6);
#pragma unroll
                    for (int j = 0; j < 8; ++j) { const float ang = pp * inv[j]; cs[j] = __cosf(ang); sn[j] = first ? -__sinf(ang) : __sinf(ang); } }
#pragma unroll
                for (int bj = 0; bj < 2; ++bj) { f32x4 v0 = acc[ai][bj][m][0], v1 = acc[ai][bj][m][1];
                    if (rope) { f32x4 p0, p1;
#pragma unroll
                        for (int q = 0; q < 4; ++q) { p0[q] = __shfl_xor(v0[q], 32); p1[q] = __shfl_xor(v1[q], 32); }
#pragma unroll
                        for (int q = 0; q < 4; ++q) { v0[q] = v0[q] * cs[q] + p0[q] * sn[q]; v1[q] = v1[q] * cs[4 + q] + p1[q] * sn[4 + q]; } }
                    pg8::u32x4 w; w.x = pg8::cvt_pk_bf16(v0[0], v0[1]); w.y = pg8::cvt_pk_bf16(v0[2], v0[3]); w.z = pg8::cvt_pk_bf16(v1[0], v1[1]); w.w = pg8::cvt_pk_bf16(v1[2], v1[3]);
                    *(pg8::u32x4*)((char*)U + (roff + bj * 256)) = w; } }
    }
};
__device__ __forceinline__ void ph_gemm_in(const Ctx& c, int l) {
    SchedIn S{(const char*)c.H(), (const char*)(c.ws + WS_WIN) + (size_t)l * NIN * D * 2, l, c.nb, c.bid};
    EpiU E{c.U()};
    pg8::gemm_phase<D * 2, false, false>(c.lds, c.lds + LDS_IDX, S, E, c.tid);
}
struct SchedOut { const char* A; const char* Bt; int nM, G, c;
    __device__ __forceinline__ bool next(int i, Unit& u) const { const int Ge = (G == 256 && nM == MT / 256) ? G_OUT0 : G; const int L = i * Ge + c; if (L >= nM * (D / 256)) return false; int pm, pn; pg8::tile_order(L, nM, D / 256, pm, pn); u.row0 = pm * 256; u.col0 = pn * 256; u.e = 0; return true; }
    __device__ __forceinline__ const char* a_base(const Unit& u) const { return A + (size_t)u.row0 * D * 2; }
    __device__ __forceinline__ const int* a_idx(const Unit&) const { return nullptr; }
    __device__ __forceinline__ const char* b_base(const Unit& u) const { return Bt + (size_t)u.col0 * D * 2; }
};
struct EpiX1 { static constexpr bool PERM = true; const Ctx* c; int l; bf16_t* X1;
    __device__ __forceinline__ void operator()(const f32x4 (&acc)[2][2][4][2], const Unit& u, int wr, int wc, int fr, int fq) const {
        const char* xin = (const char*)c->XB();
        const int colq = u.col0 + wc * 32 + 8 * fq, rowq = u.row0 + wr * 64 + fr;
        f32x4 g1v[2][2];
        { const char* g1p = (const char*)c->mod(); const unsigned goff = (unsigned)((l * 9 + mod_row(u.row0)) * MODW + 2 * D + colq) * 4u;
#pragma unroll
          for (int bj = 0; bj < 2; ++bj) { g1v[bj][0] = *(const f32x4*)(g1p + (goff + bj * 512)); g1v[bj][1] = *(const f32x4*)(g1p + (goff + bj * 512 + 16)); } }
#pragma unroll
        for (int gi = 0; gi < 8; ++gi) {
            const int ai = gi >> 2, m = gi & 3; const unsigned eoff = (unsigned)((rowq + ai * 128 + m * 16) * D + colq) * 2u;
#pragma unroll
            for (int bj = 0; bj < 2; ++bj) { const pg8::u32x4 xv = *(const pg8::u32x4*)(xin + (eoff + bj * 256));
                const f32x4 x0 = (f32x4){__uint_as_float(xv.x << 16), __uint_as_float(xv.x & 0xffff0000u), __uint_as_float(xv.y << 16), __uint_as_float(xv.y & 0xffff0000u)};
                const f32x4 x1 = (f32x4){__uint_as_float(xv.z << 16), __uint_as_float(xv.z & 0xffff0000u), __uint_as_float(xv.w << 16), __uint_as_float(xv.w & 0xffff0000u)};
                const f32x4 v0 = x0 + g1v[bj][0] * acc[ai][bj][m][0], v1 = x1 + g1v[bj][1] * acc[ai][bj][m][1];
                pg8::u32x4 w; w.x = pg8::cvt_pk_bf16(v0[0], v0[1]); w.y = pg8::cvt_pk_bf16(v0[2], v0[3]); w.z = pg8::cvt_pk_bf16(v1[0], v1[1]); w.w = pg8::cvt_pk_bf16(v1[2], v1[3]);
                *(pg8::u32x4*)((char*)X1 + (eoff + bj * 256)) = w; }
        }
    }
};
__device__ __forceinline__ void ph_gemm_out(const Ctx& c, int l) {
    SchedOut S{(const char*)c.YM(), (const char*)(c.ws + WS_WOUT) + (size_t)l * D * D * 2, (l == 0 ? MT : TL) / 256, c.nb, c.bid};
    EpiX1 E{&c, l, c.XA()};
    pg8::gemm_phase<D * 2, false, false>(c.lds, c.lds + LDS_IDX, S, E, c.tid);
}

__device__ __forceinline__ void tile_rows(int tile, int& rowbase, int& L, int& t0) {
    if (tile < TL / 32) { const int b = tile / (SEQ / 32); rowbase = b * SEQ; L = SEQ; t0 = (tile % (SEQ / 32)) * 32; }
    else { const int tc = tile - TL / 32, b = tc / (CTXL / 32); rowbase = TL + b * CTXL; L = CTXL; t0 = (tc % (CTXL / 32)) * 32; }
}
typedef unsigned u32x4_t __attribute__((ext_vector_type(4)));
__device__ __forceinline__ void unpack8(const u32x4_t v, float (&f)[8]) {
#pragma unroll
    for (int i = 0; i < 4; ++i) { f[2 * i] = __uint_as_float(v[i] << 16); f[2 * i + 1] = __uint_as_float(v[i] & 0xffff0000u); }
}
__device__ __forceinline__ void conva_item(const Ctx& c, int l, int tile) {
    lfloat* zs = (lfloat*)c.lds;
    const int tid = c.tid; int rowbase, L, t0; tile_rows(tile, rowbase, L, t0);
    const char* U = (const char*)c.U();
    __syncthreads();
#pragma unroll
    for (int p = 0; p < 8; ++p) { const int idx = p * 512 + tid, rr = idx >> 6, g = idx & 63, t = t0 - 15 + rr;
        { float z[8];
            { const bool ok = (t >= 0 && t < L); const int tc = ok ? t : t0;
                const unsigned off = (unsigned)((rowbase + tc) * NIN + g * 8) * 2u; const u32x4_t vv = *(const u32x4_t*)(U + off), gg = *(const u32x4_t*)(U + off + 1024u);
                float vf[8], gf[8]; unpack8(vv, vf); unpack8(gg, gf); const float mk = ok ? 1.f : 0.f;
#pragma unroll
                for (int i = 0; i < 8; ++i) z[i] = mk * vf[i] * sigmoidf_(gf[i]); }
            lds_st4(zs + rr * 512 + g * 8, make_float4(z[0], z[1], z[2], z[3])); lds_st4(zs + rr * 512 + g * 8 + 4, make_float4(z[4], z[5], z[6], z[7])); } }
    __syncthreads();
    { const int ch = tid; float zr[62], w[31];
      { const float* wb = c.I(I_CAW) + (size_t)l * 31 * GW + ch; asm volatile("" : "+v"(wb));
#pragma unroll
        for (int k = 0; k < 31; ++k) w[k] = wb[k * GW]; }
#pragma unroll
      for (int r = 0; r < 62; ++r) zr[r] = zs[r * 512 + ch];
      const float cb = c.I(I_CAB)[l * GW + ch];
#pragma unroll
      for (int r = 0; r < 32; ++r) { float acc = cb;
#pragma unroll
          for (int k = 0; k < 31; ++k) acc += w[k] * zr[r + k];
          zs[r * 512 + ch] = acc; } }
    __syncthreads();
    { const int lane = c.lane, wave = c.wave; const float* gp = c.I(I_LNAG) + l * GW + lane * 8; const float* bp = c.I(I_LNAB) + l * GW + lane * 8;
      const float4 g0 = *(const float4*)gp, g1 = *(const float4*)(gp + 4), b0 = *(const float4*)bp, b1 = *(const float4*)(bp + 4);
      const float gg[8] = {g0.x, g0.y, g0.z, g0.w, g1.x, g1.y, g1.z, g1.w}, bb[8] = {b0.x, b0.y, b0.z, b0.w, b1.x, b1.y, b1.z, b1.w};
#pragma unroll
      for (int q = 0; q < 4; ++q) { const int r = wave * 4 + q; const float4 v0 = lds_ld4(zs + r * 512 + lane * 8), v1 = lds_ld4(zs + r * 512 + lane * 8 + 4);
          float v[8] = {v0.x, v0.y, v0.z, v0.w, v1.x, v1.y, v1.z, v1.w}; float sm = 0.f;
#pragma unroll
          for (int i = 0; i < 8; ++i) sm += v[i];
          const float mu = wave_sum(sm) * (1.f / GW); float sq = 0.f;
#pragma unroll
          for (int i = 0; i < 8; ++i) { v[i] -= mu; sq += v[i] * v[i]; }
          const float rstd = rsqrtf(wave_sum(sq) * (1.f / GW) + EPS);
#pragma unroll
          for (int i = 0; i < 8; ++i) { const float y = v[i] * rstd * gg[i] + bb[i]; v[i] = y * sigmoidf_(y); }
          *(uint4*)((char*)c.YM() + (unsigned)((rowbase + t0 + r) * D + lane * 8) * 2u) = make_uint4(pk2(v[0], v[1]), pk2(v[2], v[3]), pk2(v[4], v[5]), pk2(v[6], v[7])); } }
}
__device__ __forceinline__ void convc_item(const Ctx& c, int l, int tile) {
    const int lane = c.lane, wave = c.wave; int rowbase, L, t0; tile_rows(tile, rowbase, L, t0);
    const char* U = (const char*)c.U();
    float w0[8], w1[8], w2[8], gn[8];
    { const float* wp = c.I(I_CCW) + (size_t)l * 3 * GW + lane * 8; const float* gp = c.I(I_NCG) + l * GW + lane * 8;
#pragma unroll
      for (int i = 0; i < 8; ++i) { w0[i] = wp[i]; w1[i] = wp[GW + i]; w2[i] = wp[2 * GW + i]; gn[i] = gp[i]; } }
    const int tw = t0 + wave * 4;
    u32x4_t cgr[6], vvr[6], bgr[4]; float mk[6];
#pragma unroll
    for (int k = 0; k < 6; ++k) { const int tt = tw - 1 + k; const bool ok = (tt >= 0 && tt < L); const unsigned o2 = (unsigned)((rowbase + (ok ? tt : tw)) * NIN + 2560 + lane * 8) * 2u; mk[k] = ok ? 1.f : 0.f;
        cgr[k] = *(const u32x4_t*)(U + o2 + 1024u); vvr[k] = *(const u32x4_t*)(U + o2 + 2048u); }
#pragma unroll
    for (int q = 0; q < 4; ++q) bgr[q] = *(const u32x4_t*)(U + (unsigned)((rowbase + tw + q) * NIN + 2560 + lane * 8) * 2u);
    float p[6][8];
#pragma unroll
    for (int k = 0; k < 6; ++k) { float cg[8], vv[8]; unpack8(cgr[k], cg); unpack8(vvr[k], vv);
#pragma unroll
        for (int i = 0; i < 8; ++i) p[k][i] = mk[k] * cg[i] * vv[i]; }
#pragma unroll
    for (int q = 0; q < 4; ++q) { float y[8], bg[8]; unpack8(bgr[q], bg); float sq = 0.f;
#pragma unroll
        for (int i = 0; i < 8; ++i) { y[i] = bg[i] * (w0[i] * p[q][i] + w1[i] * p[q + 1][i] + w2[i] * p[q + 2][i]); sq += y[i] * y[i]; }
        const float rstd = rsqrtf(wave_sum(sq) * (1.f / GW) + EPS);
#pragma unroll
        for (int i = 0; i < 8; ++i) y[i] *= rstd * gn[i];
        *(uint4*)((char*)c.YM() + (unsigned)((rowbase + tw + q) * D + 1024 + lane * 8) * 2u) = make_uint4(pk2(y[0], y[1]), pk2(y[2], y[3]), pk2(y[4], y[5]), pk2(y[6], y[7])); }
}
__device__ __forceinline__ float gelu_tanh(float x) { const float u = 0.7978845608028654f * (x + 0.044715f * x * x * x); const float e = __expf(2.f * u); return x * (1.f - __builtin_amdgcn_rcpf(e + 1.f)); }
namespace lru {
using bf16x8 = __attribute__((ext_vector_type(8))) short;
using f32x16 = __attribute__((ext_vector_type(16))) float;
__device__ __forceinline__ int crow(int r, int hi) { return (r & 3) + 8 * (r >> 2) + 4 * hi; }
__device__ __forceinline__ bf16x8 ident_frag(int ks, int nt, int n, int hi) {
    const int e0 = 32 * nt + n - 16 * ks - 8 * hi; bf16x8 v;
#pragma unroll
    for (int e = 0; e < 8; ++e) v[e] = (e == e0) ? (short)0x3F80 : (short)0;
    return v;
}
template <int MODE, int DIR>
__device__ __forceinline__ void lru_dir(const Ctx& c, int l, const char* U, const bf16_t* WG, float* SP, lfloat* yl, int b, int cidx, int rowbase, int L, int t0, int blk, int n, int hi) {
    const int ld = l * 2 + DIR; const bool is_ctx = cidx < NCC;
    float pin0 = 0.f, pin1 = 0.f;
    if constexpr (MODE == 1) {
        const char* spb = (const char*)(SP + ((size_t)(DIR * NB + b) * NCHUNK) * 2 * GW); const unsigned cho = (unsigned)(blk * 64 + n) * 4u;
        int n1, s1, n2 = 0, s2 = 0;
        if (DIR == 0) { s1 = 0; n1 = cidx; } else if (is_ctx) { s1 = NCC - 1; n1 = NCC - 1 - cidx; } else { s1 = NCC - 1; n1 = NCC; s2 = NCHUNK - 1; n2 = NCHUNK - 1 - cidx; }
        constexpr int STEP = DIR == 0 ? 1 : -1;
#pragma unroll 1
        for (int run = 0; run < 2; ++run) { const int st = run ? s2 : s1, nn = run ? n2 : n1;
#pragma unroll 1
            for (int k0 = 0; k0 < nn; k0 += 8) { float fa0[8], fb0[8], fa1[8], fb1[8];
#pragma unroll
                for (int k = 0; k < 8; ++k) { const bool ok = k0 + k < nn; const unsigned co = (unsigned)((ok ? st + STEP * (k0 + k) : st) * 2 * GW) * 4u + cho;
                    const float a0 = *(const float*)(spb + co), b0 = *(const float*)(spb + (co + GW * 4u)), a1 = *(const float*)(spb + (co + 128u)), b1 = *(const float*)(spb + (co + GW * 4u + 128u));
                    fa0[k] = ok ? a0 : 1.f; fb0[k] = ok ? b0 : 0.f; fa1[k] = ok ? a1 : 1.f; fb1[k] = ok ? b1 : 0.f; }
#pragma unroll
                for (int k = 0; k < 8; ++k) { pin0 = fa0[k] * pin0 + fb0[k]; pin1 = fa1[k] * pin1 + fb1[k]; } } }
    }
    bf16x8 af[2][4];
#pragma unroll
    for (int ks = 0; ks < 4; ++ks) {
        const int c0 = blk * 64 + 16 * ks + 8 * hi;
        float cw[4][8], cb[8];
        { const float* wp = c.I(I_LCW) + (size_t)ld * 4 * GW + c0; const float* bp = c.I(I_LCB) + ld * GW + c0;
#pragma unroll
          for (int k = 0; k < 4; ++k) { const float4 w0 = *(const float4*)(wp + k * GW), w1 = *(const float4*)(wp + k * GW + 4); cw[k][0] = w0.x; cw[k][1] = w0.y; cw[k][2] = w0.z; cw[k][3] = w0.w; cw[k][4] = w1.x; cw[k][5] = w1.y; cw[k][6] = w1.z; cw[k][7] = w1.w; }
          const float4 b0 = *(const float4*)bp, b1 = *(const float4*)(bp + 4); cb[0] = b0.x; cb[1] = b0.y; cb[2] = b0.z; cb[3] = b0.w; cb[4] = b1.x; cb[5] = b1.y; cb[6] = b1.z; cb[7] = b1.w; }
#pragma unroll
        for (int rt = 0; rt < 2; ++rt) { const int t = t0 + rt * 32 + n; float acc[8];
#pragma unroll
            for (int i = 0; i < 8; ++i) acc[i] = cb[i];
#pragma unroll
            for (int k = 0; k < 4; ++k) { const int tt = t + k - (DIR == 0 ? 3 : 0);
                const bool ok = (tt >= 0 && tt < L); const int tc = ok ? tt : t; const float mk = ok ? 1.f : 0.f;
                float x[8]; unpack8(*(const u32x4_t*)(U + (unsigned)((rowbase + tc) * NIN + 4608 + c0) * 2u), x);
#pragma unroll
                for (int i = 0; i < 8; ++i) acc[i] += (mk * cw[k][i]) * x[i]; }
            u32x4_t pk; pk[0] = pk2(acc[0], acc[1]); pk[1] = pk2(acc[2], acc[3]); pk[2] = pk2(acc[4], acc[5]); pk[3] = pk2(acc[6], acc[7]);
            af[rt][ks] = __builtin_bit_cast(bf16x8, pk); }
    }
#pragma unroll 1
    for (int nt = 0; nt < 2; ++nt) {
        const int ch = blk * 64 + nt * 32 + n;
        f32x16 accA[2], accX[2], accV[2];
#pragma unroll
        for (int rt = 0; rt < 2; ++rt) { accA[rt] = f32x16{}; accX[rt] = f32x16{}; accV[rt] = f32x16{}; }
        { const bf16_t* wa = WG + ((size_t)((ld * 2 + 0) * 8 + blk) * 64 + nt * 32 + n) * 64 + 8 * hi; const bf16_t* wx = wa + 8 * 64 * 64;
#pragma unroll
          for (int ks = 0; ks < 4; ++ks) { const bf16x8 bA = *(const bf16x8*)(wa + 16 * ks), bX = *(const bf16x8*)(wx + 16 * ks), bI = ident_frag(ks, nt, n, hi);
#pragma unroll
              for (int rt = 0; rt < 2; ++rt) { accA[rt] = __builtin_amdgcn_mfma_f32_32x32x16_bf16(af[rt][ks], bA, accA[rt], 0, 0, 0); accX[rt] = __builtin_amdgcn_mfma_f32_32x32x16_bf16(af[rt][ks], bX, accX[rt], 0, 0, 0);
                  accV[rt] = __builtin_amdgcn_mfma_f32_32x32x16_bf16(af[rt][ks], bI, accV[rt], 0, 0, 0); } } }
        { const float bav = c.I(I_LBA)[ld * GW + ch], bxv = c.I(I_LBX)[ld * GW + ch], lamv = c.I(I_LLAM)[ld * GW + ch];
          const float sp8 = -8.f * 1.4426950408889634f * log1pf(__expf(-lamv));
#pragma unroll
          for (int rt = 0; rt < 2; ++rt)
#pragma unroll
            for (int r = 0; r < 16; ++r) { const float rg = sigmoidf_(accA[rt][r] + bav), ig = sigmoidf_(accX[rt][r] + bxv); const float a = __builtin_amdgcn_exp2f(rg * sp8);
                accA[rt][r] = a; accX[rt][r] = __builtin_amdgcn_sqrtf(fmaxf(fmaf(-a, a, 1.f), 0.f)) * (ig * accV[rt][r]); } }
        float cA[2][4], cB[2][4], pA[2][4], pB[2][4];
#pragma unroll
        for (int rt = 0; rt < 2; ++rt)
#pragma unroll
            for (int q = 0; q < 4; ++q) { const float a0 = accA[rt][4 * q + (DIR ? 3 : 0)], a1 = accA[rt][4 * q + (DIR ? 2 : 1)], a2 = accA[rt][4 * q + (DIR ? 1 : 2)], a3 = accA[rt][4 * q + (DIR ? 0 : 3)];
                const float b0 = accX[rt][4 * q + (DIR ? 3 : 0)], b1 = accX[rt][4 * q + (DIR ? 2 : 1)], b2 = accX[rt][4 * q + (DIR ? 1 : 2)], b3 = accX[rt][4 * q + (DIR ? 0 : 3)];
                cA[rt][q] = (a0 * a1) * (a2 * a3); cB[rt][q] = ((b0 * a1 + b1) * a2 + b2) * a3 + b3;
                pA[rt][q] = __shfl_xor(cA[rt][q], 32); pB[rt][q] = __shfl_xor(cB[rt][q], 32); }
        float p = (MODE == 1) ? (nt == 0 ? pin0 : pin1) : 0.f, aprod = 1.f;
        float hs[16];
#pragma unroll
        for (int s2 = 0; s2 < 16; ++s2) { const int k = DIR ? 15 - s2 : s2, rt = k >> 3, q = (k >> 1) & 3; const bool own = ((k & 1) == hi);
            const float Ak = own ? cA[rt][q] : pA[rt][q], Bk = own ? cB[rt][q] : pB[rt][q];
            hs[k] = p; p = Ak * p + Bk; aprod *= Ak; }
        if constexpr (MODE == 0) { if (hi == 0) { float* spo = SP + ((size_t)((DIR * NB + b) * NCHUNK + cidx)) * 2 * GW + ch; spo[0] = aprod; spo[GW] = p; } }
        else {
#pragma unroll
            for (int rt = 0; rt < 2; ++rt)
#pragma unroll
                for (int q = 0; q < 4; ++q) { float h = hi ? hs[2 * q + 1 + 8 * rt] : hs[2 * q + 8 * rt];
#pragma unroll
                    for (int e = 0; e < 4; ++e) { const int r = 4 * q + (DIR ? 3 - e : e); h = accA[rt][r] * h + accX[rt][r]; lfloat* yp = yl + ((nt * 2 + rt) * 16 + r) * 512; if (DIR == 0) *yp = h; else *yp += h; } }
        }
    }
}
template <int MODE> __device__ __forceinline__ void lru_item(const Ctx& c, int l, int b, int cidx) {
    const int blk = c.wave, n = c.lane & 31, hi = c.lane >> 5;
    const bool is_ctx = cidx < NCC;
    const int L = is_ctx ? CTXL : SEQ, t0 = (is_ctx ? cidx : cidx - NCC) * 64, rowbase = is_ctx ? TL + b * CTXL : b * SEQ;
    const char* U = (const char*)c.U(); const bf16_t* WG = (const bf16_t*)(c.ws + WS_WG); float* SP = (float*)(c.ws + WS_SP);
    if constexpr (MODE == 1) __syncthreads();
    lfloat* yl = (lfloat*)c.lds + c.tid;
    lru_dir<MODE, 0>(c, l, U, WG, SP, yl, b, cidx, rowbase, L, t0, blk, n, hi);
    lru_dir<MODE, 1>(c, l, U, WG, SP, yl, b, cidx, rowbase, L, t0, blk, n, hi);
    if constexpr (MODE == 1) {
        lfloat* red = (lfloat*)(c.lds + LDS_MISC);
#pragma unroll 1
        for (int nt = 0; nt < 2; ++nt) { f32x16 accG[2];
#pragma unroll
            for (int rt = 0; rt < 2; ++rt) accG[rt] = f32x16{};
#pragma unroll
            for (int ks = 0; ks < 4; ++ks) { const bf16x8 bI = ident_frag(ks, nt, n, hi);
#pragma unroll
                for (int rt = 0; rt < 2; ++rt) { const bf16x8 ga = *(const bf16x8*)(U + (unsigned)((rowbase + t0 + rt * 32 + n) * NIN + 4096 + blk * 64 + 16 * ks + 8 * hi) * 2u);
                    accG[rt] = __builtin_amdgcn_mfma_f32_32x32x16_bf16(ga, bI, accG[rt], 0, 0, 0); } }
#pragma unroll
            for (int rt = 0; rt < 2; ++rt)
#pragma unroll
                for (int r = 0; r < 16; ++r) yl[((nt * 2 + rt) * 16 + r) * 512] *= gelu_tanh(accG[rt][r]); }
        float yall[2][2][16];
#pragma unroll
        for (int nt = 0; nt < 2; ++nt)
#pragma unroll
            for (int rt = 0; rt < 2; ++rt)
#pragma unroll
                for (int r = 0; r < 16; ++r) yall[nt][rt][r] = yl[((nt * 2 + rt) * 16 + r) * 512];
        __syncthreads();
#pragma unroll
        for (int rt = 0; rt < 2; ++rt)
#pragma unroll
            for (int r = 0; r < 16; ++r) { float sq = yall[0][rt][r] * yall[0][rt][r] + yall[1][rt][r] * yall[1][rt][r];
                sq += __shfl_xor(sq, 1); sq += __shfl_xor(sq, 2); sq += __shfl_xor(sq, 4); sq += __shfl_xor(sq, 8); sq += __shfl_xor(sq, 16);
                if (n == 0) red[blk * 64 + rt * 32 + crow(r, hi)] = sq; }
        __syncthreads();
        if (c.tid < 64) { float t = 0.f;
#pragma unroll
            for (int w = 0; w < 8; ++w) t += red[w * 64 + c.tid];
            red[512 + c.tid] = rsqrtf(t * (1.f / GW) + EPS); }
        __syncthreads();
        const float g0 = c.I(I_NDG)[l * GW + blk * 64 + n], g1 = c.I(I_NDG)[l * GW + blk * 64 + 32 + n];
        char* YMc = (char*)c.YM();
        LAS char* stg = (LAS char*)c.lds + blk * (64 * 144);
#pragma unroll
        for (int rt = 0; rt < 2; ++rt)
#pragma unroll
            for (int r = 0; r < 16; ++r) { const int row = rt * 32 + crow(r, hi); const float rs = red[512 + row];
                *(LAS bf16_t*)(stg + row * 144 + n * 2) = (bf16_t)f2bf(yall[0][rt][r] * rs * g0); *(LAS bf16_t*)(stg + row * 144 + (32 + n) * 2) = (bf16_t)f2bf(yall[1][rt][r] * rs * g1); }
        asm volatile("s_waitcnt lgkmcnt(0)" ::: "memory");
#pragma unroll
        for (int it = 0; it < 8; ++it) { const int q = it * 64 + (int)c.lane, row = q >> 3, c16 = q & 7;
            const u32x4_t v = *(const LAS u32x4_t*)(stg + row * 144 + c16 * 16);
            *(u32x4_t*)(YMc + (unsigned)((rowbase + t0 + row) * D + 1536 + blk * 64 + c16 * 8) * 2u) = v; }
    }
}
}

__device__ __forceinline__ void ph_convert_router(const Ctx& c) {
    uint4* RWF = (uint4*)(c.ws + WS_RWF);
    for (int idx = c.bid * 512 + c.tid; idx < 2 * 8 * 8 * 2 * 64; idx += c.nb * 512) {
        const int lane = idx & 63, nt = (idx >> 6) & 1, ks = (idx >> 7) & 7, w = (idx >> 10) & 7, l = idx >> 13, fr = lane & 15, fq = lane >> 4;
        const float* rwp = c.I(I_RW) + ((size_t)l * D + w * 256 + 32 * ks + 8 * fq) * NE + 16 * nt + fr;
        unsigned hi[4], lo[4];
#pragma unroll
        for (int j2 = 0; j2 < 4; ++j2) { const float w0 = rwp[(size_t)(2 * j2) * NE], w1 = rwp[(size_t)(2 * j2 + 1) * NE]; const unsigned h0 = f2bf(w0), h1 = f2bf(w1);
            hi[j2] = h0 | (h1 << 16); lo[j2] = pk2(w0 - __uint_as_float(h0 << 16), w1 - __uint_as_float(h1 << 16)); }
        RWF[(size_t)(idx >> 6) * 128 + lane] = make_uint4(hi[0], hi[1], hi[2], hi[3]); RWF[(size_t)(idx >> 6) * 128 + 64 + lane] = make_uint4(lo[0], lo[1], lo[2], lo[3]);
    }
}
__device__ __forceinline__ void ph_convert_lru(const Ctx& c) {
    bf16_t* WG = (bf16_t*)(c.ws + WS_WG);
    for (int idx = c.bid * 512 + c.tid; idx < 4 * 2 * 8 * 64 * 64; idx += c.nb * 512) {
        const int i = idx & 63, j = (idx >> 6) & 63, blk = (idx >> 12) & 7, g = (idx >> 15) & 1, ld = idx >> 16;
        const float* src = (g == 0) ? c.I(I_LWA) : c.I(I_LWX);
        WG[idx] = (bf16_t)f2bf(src[((size_t)(ld * 8 + blk) * 64 + i) * 64 + j]);
    }
}

namespace att {
using bf16x8 = __attribute__((ext_vector_type(8))) short;
using s16x4  = __attribute__((ext_vector_type(4))) short;
using f32x16 = __attribute__((ext_vector_type(16))) float;
using u32x4  = __attribute__((ext_vector_type(4))) unsigned;
constexpr int SHM_V = 64 * 128 * 2, SHM_K = 64 * 64 * 2, OFF_K = 2 * SHM_V, OFF_W = OFF_K + 2 * SHM_K, OFF_STG = OFF_W + 8 * 256, LDS_NEED = OFF_STG + 8 * 32 * 272;
static_assert(LDS_NEED <= 131072, "attention LDS");
constexpr float SCALE = 0.125f, THR = 8.f;
#define K64SWZ(row, colB) ((row) * 128 + ((colB) ^ ((((row) >> 1) & 7) << 4)))
#define SBAR() __builtin_amdgcn_sched_barrier(0)
__device__ __forceinline__ int crow(int r, int hi) { return (r & 3) + 8 * (r >> 2) + 4 * hi; }
__device__ __forceinline__ unsigned cvtpk(float lo, float hi) { unsigned r; asm volatile("v_cvt_pk_bf16_f32 %0, %1, %2" : "=v"(r) : "v"(lo), "v"(hi)); return r; }
__device__ __forceinline__ void partialSM(f32x16& p0, f32x16& p1, float& m_reg, float& mn, float& alpha) {
    constexpr float C = SCALE * 1.4426950408889634f;
    float pmax = p0[0];
#pragma unroll
    for (int r = 1; r < 16; ++r) pmax = fmaxf(pmax, p0[r]);
#pragma unroll
    for (int r = 0; r < 16; ++r) pmax = fmaxf(pmax, p1[r]);
    { auto rr = __builtin_amdgcn_permlane32_swap(__float_as_uint(pmax), __float_as_uint(pmax), false, false); pmax = fmaxf(__uint_as_float(rr[0]), __uint_as_float(rr[1])); }
    if (__builtin_expect(__all(pmax - m_reg <= THR / SCALE), 1)) { mn = m_reg; alpha = 1.f; }
    else { mn = fmaxf(m_reg, pmax); alpha = __builtin_amdgcn_exp2f((m_reg - mn) * C); m_reg = mn; }
    const float mnC = -mn * C;
#pragma unroll
    for (int r = 0; r < 16; ++r) p0[r] = fmaf(p0[r], C, mnC);
#pragma unroll
    for (int r = 0; r < 16; ++r) p1[r] = fmaf(p1[r], C, mnC);
#pragma unroll
    for (int r = 0; r < 16; ++r) p0[r] = __builtin_amdgcn_exp2f(p0[r]);
}
__device__ __forceinline__ void finishSM(f32x16& p0, f32x16& p1, float alpha, float& l_reg, bf16x8& pa0, bf16x8& pa1, bf16x8& pa2, bf16x8& pa3) {
#pragma unroll
    for (int r = 0; r < 16; ++r) p1[r] = __builtin_amdgcn_exp2f(p1[r]);
    float ps = 0;
#pragma unroll
    for (int r = 0; r < 16; ++r) ps += p0[r];
#pragma unroll
    for (int r = 0; r < 16; ++r) ps += p1[r];
    { auto rr = __builtin_amdgcn_permlane32_swap(__float_as_uint(ps), __float_as_uint(ps), false, false); ps = __uint_as_float(rr[0]) + __uint_as_float(rr[1]); }
    l_reg = l_reg * alpha + ps;
#define PK4(P, BASE, OUT) do { unsigned a0 = cvtpk(P[BASE + 0], P[BASE + 1]), a1 = cvtpk(P[BASE + 2], P[BASE + 3]);   \
    unsigned b0 = cvtpk(P[BASE + 4], P[BASE + 5]), b1 = cvtpk(P[BASE + 6], P[BASE + 7]);                              \
    auto r0 = __builtin_amdgcn_permlane32_swap(a0, b0, false, false); auto r1 = __builtin_amdgcn_permlane32_swap(a1, b1, false, false); \
    u32x4 w = {r0[0], r1[0], r0[1], r1[1]}; OUT = __builtin_bit_cast(bf16x8, w); } while (0)
    PK4(p0, 0, pa0); PK4(p0, 8, pa1); PK4(p1, 0, pa2); PK4(p1, 8, pa3);
#undef PK4
}
__device__ __forceinline__ void qkt(f32x16& p0, f32x16& p1, const LAS char* Ks, const bf16x8* qr, int r32, int hi) {
    p0 = f32x16{}; p1 = f32x16{};
#pragma unroll
    for (int d0 = 0; d0 < 4; ++d0) { const int cb = (d0 * 16 + hi * 8) * 2;
        const bf16x8 b0 = *(const LAS bf16x8*)(Ks + K64SWZ(r32, cb));
        const bf16x8 b1 = *(const LAS bf16x8*)(Ks + K64SWZ(32 + r32, cb));
        p0 = __builtin_amdgcn_mfma_f32_32x32x16_bf16(b0, qr[d0], p0, 0, 0, 0);
        p1 = __builtin_amdgcn_mfma_f32_32x32x16_bf16(b1, qr[d0], p1, 0, 0, 0); }
}
__device__ __forceinline__ int v_st(int k, int c) { const int kk = (k & ~0xC) | ((k & 4) << 1) | ((k & 8) >> 1); return ((kk >> 3) * 4 + (c >> 5)) * 512 + ((kk & 7) * 32 + (c & 31)) * 2; }
__device__ __forceinline__ int v_rd_base(int lane) { return ((lane & 3) << 3) | (((lane >> 2) & 3) << 6) | (((lane >> 4) & 1) << 5) | (((lane >> 5) & 1) << 8); }
constexpr int v_rd_off(int d0, int ks, int half) { return d0 * 512 + ks * 4096 + half * 2048; }
template <int OFF> __device__ __forceinline__ s16x4 tr_read(int vb) { s16x4 r; asm volatile("ds_read_b64_tr_b16 %0, %1 offset:%2" : "=&v"(r) : "v"(vb), "i"(OFF) : "memory"); return r; }
template <int D0> __device__ __forceinline__ void pv_one(f32x16& od, int vb, bf16x8 pa0, bf16x8 pa1, bf16x8 pa2, bf16x8 pa3) {
    const s16x4 l0 = tr_read<v_rd_off(D0, 0, 0)>(vb), h0 = tr_read<v_rd_off(D0, 0, 1)>(vb), l1 = tr_read<v_rd_off(D0, 1, 0)>(vb), h1 = tr_read<v_rd_off(D0, 1, 1)>(vb);
    const s16x4 l2 = tr_read<v_rd_off(D0, 2, 0)>(vb), h2 = tr_read<v_rd_off(D0, 2, 1)>(vb), l3 = tr_read<v_rd_off(D0, 3, 0)>(vb), h3 = tr_read<v_rd_off(D0, 3, 1)>(vb);
    asm volatile("s_waitcnt lgkmcnt(0)" ::: "memory"); SBAR();
#define PK(L, H) (bf16x8){L[0], L[1], L[2], L[3], H[0], H[1], H[2], H[3]}
    od = __builtin_amdgcn_mfma_f32_32x32x16_bf16(pa0, PK(l0, h0), od, 0, 0, 0);
    od = __builtin_amdgcn_mfma_f32_32x32x16_bf16(pa1, PK(l1, h1), od, 0, 0, 0);
    od = __builtin_amdgcn_mfma_f32_32x32x16_bf16(pa2, PK(l2, h2), od, 0, 0, 0);
    od = __builtin_amdgcn_mfma_f32_32x32x16_bf16(pa3, PK(l3, h3), od, 0, 0, 0);
#undef PK
}
__device__ __forceinline__ void pv_d0(f32x16* o, int vb, bf16x8 pa0, bf16x8 pa1, bf16x8 pa2, bf16x8 pa3) {
    pv_one<0>(o[0], vb, pa0, pa1, pa2, pa3); pv_one<1>(o[1], vb, pa0, pa1, pa2, pa3); pv_one<2>(o[2], vb, pa0, pa1, pa2, pa3); pv_one<3>(o[3], vb, pa0, pa1, pa2, pa3);
}
template <bool GA> __device__ __forceinline__ void attn_unit(const bf16_t* __restrict__ U, bf16_t* __restrict__ YM, float* __restrict__ stash, const float* __restrict__ ng, float lam, float lam_init,
                                          int qrow0, int b, int dh, int NT, LAS char* lds, int wid) {
    const int lane = pg8::fresh_lane(), tid = wid * 64 + lane, r32 = lane & 31, hi = lane >> 5;
    LAS char* V_lds = lds; LAS char* K_lds = lds + OFF_K;
    LAS float* wsl = (LAS float*)(lds + OFF_W) + wid * 64; LAS float* li_l = wsl; LAS float* al_l = wsl + 32;
    const int sr = tid >> 4, sc = (tid & 15) * 8, vst0 = v_st(sr, sc), vst1 = v_st(32 + sr, sc);
    const int kr = tid >> 3, kc = (tid & 7) * 8, kst = K64SWZ(kr, kc * 2);
    const int vb0 = (int)(unsigned)(size_t)V_lds + v_rd_base(lane);
    const int krow_ctx = TL + b * CTXL, krow_lat = b * SEQ - 4 * 64;
    f32x16 o[4];
#pragma unroll 1
    for (int jm = 0; jm < 2; ++jm) {
        const int hq = 2 * dh + jm;
        const unsigned koff = (unsigned)(kr * NIN + 1536 + hq * 64 + kc) * 2u, voff = (unsigned)(sr * NIN + 2048 + dh * 128 + sc) * 2u;
        float m_reg = -1e30f, l_reg = 0.f; bf16x8 qr[4];
#pragma unroll
        for (int d = 0; d < 4; ++d) o[d] = f32x16{};
        { const unsigned qoff = (unsigned)((qrow0 + wid * 32 + r32) * NIN + 1024 + hq * 64 + hi * 8) * 2u;
#pragma unroll
          for (int d0 = 0; d0 < 4; ++d0) qr[d0] = *(const bf16x8*)((const char*)U + (qoff + d0 * 32)); }
        struct { bf16x8 vs0, vs1, ks; } sr_[2];
#define KROW(kt) (((kt) < 4 ? krow_ctx : krow_lat) + (kt) * 64)
#define SLOAD(i, kt) do { const unsigned _r = (unsigned)KROW(kt) * (unsigned)(NIN * 2); sr_[i].vs0 = *(const bf16x8*)((const char*)U + (_r + voff)); sr_[i].vs1 = *(const bf16x8*)((const char*)U + (_r + voff + 32u * NIN * 2u)); \
        sr_[i].ks = *(const bf16x8*)((const char*)U + (_r + koff)); } while (0)
#define SWRITE(bf, i) do { *(LAS bf16x8*)(V_lds + (bf) * SHM_V + vst0) = sr_[i].vs0; *(LAS bf16x8*)(V_lds + (bf) * SHM_V + vst1) = sr_[i].vs1; \
        *(LAS bf16x8*)(K_lds + (bf) * SHM_K + kst) = sr_[i].ks; } while (0)
#define SWAIT() asm volatile("s_waitcnt vmcnt(3)" ::: "memory")
#define RESC(a) do { if (__any((a) < 1.f)) { if (hi == 0) al_l[r32] = (a); asm volatile("s_waitcnt lgkmcnt(0)" ::: "memory"); \
        _Pragma("unroll") for (int d = 0; d < 4; ++d) _Pragma("unroll") for (int r = 0; r < 16; ++r) o[d][r] *= al_l[crow(r, hi)]; } } while (0)
        f32x16 pA0, pA1, pB0, pB1; float mnA, mnB, alA, alB; bf16x8 pa0, pa1, pa2, pa3;
        constexpr int SE = 0, SO = 1;
        __syncthreads();
        SLOAD(SE, 0); asm volatile("s_waitcnt vmcnt(0)" ::: "memory"); SWRITE(0, SE); __syncthreads();
        qkt(pA0, pA1, K_lds, qr, r32, hi); partialSM(pA0, pA1, m_reg, mnA, alA);
        SLOAD(SO, 1); if (2 < NT) SLOAD(SE, 2);
        SWAIT(); SWRITE(1, SO); __syncthreads();
        if constexpr (GA) {
#pragma unroll 1
            for (int j = 1; j + 1 < NT; j += 2) {
                SBAR(); qkt(pB0, pB1, K_lds + SHM_K, qr, r32, hi); SBAR(); finishSM(pA0, pA1, alA, l_reg, pa0, pa1, pa2, pa3); SBAR();
                SLOAD(SO, j + 2); SBAR();
                pv_d0(o, vb0, pa0, pa1, pa2, pa3); SBAR(); partialSM(pB0, pB1, m_reg, mnB, alB);
                __syncthreads(); SWAIT(); SWRITE(0, SE);
                RESC(alB); __syncthreads();
                SBAR(); qkt(pA0, pA1, K_lds, qr, r32, hi); SBAR(); finishSM(pB0, pB1, alB, l_reg, pa0, pa1, pa2, pa3); SBAR();
                if (j + 3 < NT) SLOAD(SE, j + 3); SBAR();
                pv_d0(o, vb0 + SHM_V, pa0, pa1, pa2, pa3); SBAR(); partialSM(pA0, pA1, m_reg, mnA, alA);
                __syncthreads(); SWAIT(); SWRITE(1, SO);
                RESC(alA); __syncthreads();
            }
        } else {
#pragma unroll 1
            for (int j = 1; j + 1 < NT; j += 2) {
                SBAR(); finishSM(pA0, pA1, alA, l_reg, pa0, pa1, pa2, pa3); SBAR(); qkt(pB0, pB1, K_lds + SHM_K, qr, r32, hi); SBAR();
                SLOAD(SO, j + 2); SBAR();
                partialSM(pB0, pB1, m_reg, mnB, alB); SBAR(); pv_d0(o, vb0, pa0, pa1, pa2, pa3);
                __syncthreads(); SWAIT(); SWRITE(0, SE);
                RESC(alB); __syncthreads();
                SBAR(); finishSM(pB0, pB1, alB, l_reg, pa0, pa1, pa2, pa3); SBAR(); qkt(pA0, pA1, K_lds, qr, r32, hi); SBAR();
                if (j + 3 < NT) SLOAD(SE, j + 3); SBAR();
                partialSM(pA0, pA1, m_reg, mnA, alA); SBAR(); pv_d0(o, vb0 + SHM_V, pa0, pa1, pa2, pa3);
                __syncthreads(); SWAIT(); SWRITE(1, SO);
                RESC(alA); __syncthreads();
            }
        }
        SBAR(); qkt(pB0, pB1, K_lds + SHM_K, qr, r32, hi);
        finishSM(pA0, pA1, alA, l_reg, pa0, pa1, pa2, pa3); SBAR();
        pv_d0(o, vb0, pa0, pa1, pa2, pa3); partialSM(pB0, pB1, m_reg, mnB, alB);
        __syncthreads(); RESC(alB);
        finishSM(pB0, pB1, alB, l_reg, pa0, pa1, pa2, pa3); SBAR();
        pv_d0(o, vb0 + SHM_V, pa0, pa1, pa2, pa3);
        if (hi == 0) li_l[r32] = l_reg; asm volatile("s_waitcnt lgkmcnt(0)" ::: "memory");
#pragma unroll
        for (int r = 0; r < 16; ++r) { const float rl = __builtin_amdgcn_rcpf(li_l[crow(r, hi)]);
#pragma unroll
            for (int d = 0; d < 4; ++d) o[d][r] *= rl; }
        if (jm == 0) {
            unsigned so = (unsigned)tid * 16u;
#pragma unroll
            for (int d = 0; d < 4; ++d)
#pragma unroll
                for (int q4 = 0; q4 < 4; ++q4) { *(f32x4*)((char*)stash + so) = (f32x4){o[d][q4 * 4 + 0], o[d][q4 * 4 + 1], o[d][q4 * 4 + 2], o[d][q4 * 4 + 3]}; so += 8192u; asm volatile("" : "+v"(so)); }
        }
#undef KROW
#undef SLOAD
#undef SWRITE
#undef SWAIT
#undef RESC
    }
    float ss[16];
    const int lane_e = pg8::fresh_lane(), r32e = lane_e & 31, hie = lane_e >> 5, wide = __builtin_amdgcn_readfirstlane(wid);
    { unsigned so = (unsigned)(wide * 64 + lane_e) * 16u;
#pragma unroll
      for (int d = 0; d < 4; ++d)
#pragma unroll
        for (int q4 = 0; q4 < 4; ++q4) { const f32x4 s0 = *(const f32x4*)((const char*)stash + so); so += 8192u; asm volatile("" : "+v"(so));
#pragma unroll
            for (int e = 0; e < 4; ++e) o[d][q4 * 4 + e] = s0[e] - lam * o[d][q4 * 4 + e]; } }
#pragma unroll
    for (int r = 0; r < 16; ++r) { float a = 0.f;
#pragma unroll
        for (int d = 0; d < 4; ++d) a += o[d][r] * o[d][r];
        a += __shfl_xor(a, 1); a += __shfl_xor(a, 2); a += __shfl_xor(a, 4); a += __shfl_xor(a, 8); a += __shfl_xor(a, 16);
        ss[r] = rsqrtf(a * (1.f / 128.f) + EPS) * (1.f - lam_init); }
    float gv[4];
#pragma unroll
    for (int d = 0; d < 4; ++d) gv[d] = ng[32 * d + r32e];
    LAS char* stg = lds + OFF_STG + wide * (32 * 272);
#pragma unroll
    for (int r = 0; r < 16; ++r)
#pragma unroll
        for (int d = 0; d < 4; ++d) *(LAS bf16_t*)(stg + crow(r, hie) * 272 + (32 * d + r32e) * 2) = (bf16_t)f2bf(o[d][r] * ss[r] * gv[d]);
    asm volatile("s_waitcnt lgkmcnt(0)" ::: "memory");
#pragma unroll
    for (int it = 0; it < 8; ++it) { const int q = it * 64 + lane_e, row = q >> 4, c16 = q & 15;
        const u32x4 v = *(const LAS u32x4*)(stg + row * 272 + c16 * 16);
        *(u32x4*)((char*)YM + (unsigned)((qrow0 + wide * 32 + row) * D + 512 + dh * 128 + c16 * 8) * 2u) = v; }
}
#undef K64SWZ
#undef SBAR
}
__device__ __forceinline__ float lam_init_of(int l) { return l == 0 ? 0.2f : 0.35550906759096927f; }
__device__ __forceinline__ void ph_attention(const Ctx& c, int l) {
    float lam; { const float* lv = c.I(I_DLAM) + l * 4 * 64; float s0 = 0.f, s1 = 0.f; for (int i = 0; i < 64; ++i) { s0 += lv[i] * lv[64 + i]; s1 += lv[128 + i] * lv[192 + i]; } lam = __expf(s0) - __expf(s1) + lam_init_of(l); }
    float* stash = (float*)(c.ws + WS_OST) + (size_t)c.bid * 512 * 64;
    const float* ng = c.I(I_DNG) + l * 128;
    const int nlat = NB * 4 * (SEQ / 256), total = nlat + (l == 0 ? NB * 4 : 0);
    for (int it = c.bid; it < total; it += c.nb) {
        int b, dh, qrow0, NT;
        if (it < nlat) { b = it / 32; dh = (it / 8) & 3; qrow0 = b * SEQ + (it & 7) * 256; NT = 36; }
        else { const int r = it - nlat; b = r >> 2; dh = r & 3; qrow0 = TL + b * CTXL; NT = 4; }
        if ((c.wave & 1) == 0) att::attn_unit<true>(c.U(), c.YM(), stash, ng, lam, lam_init_of(l), qrow0, b, dh, NT, (LAS char*)c.lds, c.wave);
        else att::attn_unit<false>(c.U(), c.YM(), stash, ng, lam, lam_init_of(l), qrow0, b, dh, NT, (LAS char*)c.lds, c.wave);
    }
}

__device__ __forceinline__ void ph_norm2_router(const Ctx& c, int l) {
    typedef short bf16x8 __attribute__((ext_vector_type(8)));
    const int rows = (l == 0) ? MT : TL;
    const float* g = c.I(I_N2G) + l * D;
    const char* X1 = (const char*)c.XA();
    int* topi = (int*)(c.ws + WS_TOPI); float* gate = (float*)(c.ws + WS_GATE);
    unsigned* cnt = c.ctl() + CW_CNT + l * 32 * 64;
    constexpr int RS = 4096 + 16;
    LAS unsigned char* HH = c.lds; LAS unsigned char* HL = c.lds + 16 * RS;
    lfloat* part = (lfloat*)c.lds;
    lfloat* logit = (lfloat*)(c.lds + 2 * 16 * RS);
    lint* lcnt = (lint*)(c.lds + 2 * 16 * RS + 2048);
    if (c.tid < 32) lcnt[c.tid] = 0;
    __syncthreads();
    const int kb = c.wave * 256, fr = c.lane & 15, fq = c.lane >> 4;
    const char* rwf = (const char*)(c.ws + WS_RWF) + (size_t)(l * 8 + c.wave) * 8 * 2 * 2 * 1024;
    u32x4_t v[2][4];
    { const int r = c.bid * 16 + c.wave * 2; if (r < rows) {
#pragma unroll
        for (int i = 0; i < 2; ++i)
#pragma unroll
            for (int j = 0; j < 4; ++j) v[i][j] = *(const u32x4_t*)(X1 + (unsigned)((r + i) * D + (j * 64 + c.lane) * 8) * 2u); } }
    for (int r0 = c.bid * 16; r0 < rows; r0 += c.nb * 16) {
#pragma unroll
        for (int i = 0; i < 2; ++i) {
            const int rl = c.wave * 2 + i, r = r0 + rl;
            float ss = 0.f;
#pragma unroll
            for (int j = 0; j < 4; ++j) { float x[8]; unpack8(v[i][j], x);
#pragma unroll
                for (int q = 0; q < 8; ++q) ss += x[q] * x[q]; }
            const float rstd = rsqrtf(wave_sum(ss) * (1.f / D) + EPS);
            const float* m = c.mod() + (size_t)(l * 9 + mod_row(r)) * MODW;
            unsigned char* o = c.ws + WS_H8 + (size_t)r * D;
#pragma unroll
            for (int j = 0; j < 4; ++j) {
                const int col = (j * 64 + c.lane) * 8; float h[8], x[8]; unpack8(v[i][j], x);
#pragma unroll
                for (int q = 0; q < 2; ++q) { const unsigned co = (unsigned)(col + 4 * q) * 4u;
                    const float4 gg = *(const float4*)((const char*)g + co), sc = *(const float4*)((const char*)(m + 4 * D) + co), sh = *(const float4*)((const char*)(m + 3 * D) + co);
                    h[4 * q + 0] = x[4 * q + 0] * rstd * gg.x * (1.f + sc.x) + sh.x; h[4 * q + 1] = x[4 * q + 1] * rstd * gg.y * (1.f + sc.y) + sh.y;
                    h[4 * q + 2] = x[4 * q + 2] * rstd * gg.z * (1.f + sc.z) + sh.z; h[4 * q + 3] = x[4 * q + 3] * rstd * gg.w * (1.f + sc.w) + sh.w; }
                *(uint2*)(o + (unsigned)col) = make_uint2(pk4_fp8(h[0], h[1], h[2], h[3]), pk4_fp8(h[4], h[5], h[6], h[7]));
                u32x4_t th, tl;
#pragma unroll
                for (int q = 0; q < 4; ++q) { const unsigned a0 = f2bf(h[2 * q]), a1 = f2bf(h[2 * q + 1]); th[q] = a0 | (a1 << 16); tl[q] = pk2(h[2 * q] - __uint_as_float(a0 << 16), h[2 * q + 1] - __uint_as_float(a1 << 16)); }
                *(LAS u32x4_t*)(HH + rl * RS + col * 2) = th; *(LAS u32x4_t*)(HL + rl * RS + col * 2) = tl;
            }
            const int rn = r + c.nb * 16;
            if (rn < rows) {
#pragma unroll
                for (int j = 0; j < 4; ++j) v[i][j] = *(const u32x4_t*)(X1 + (unsigned)(rn * D + (j * 64 + c.lane) * 8) * 2u); }
            __builtin_amdgcn_sched_barrier(0);
        }
        bf16x8 bwh[8][2], bwl[8][2];
        { const unsigned lo16 = (unsigned)pg8::fresh_lane() * 16u;
#pragma unroll
          for (int ks = 0; ks < 8; ++ks)
#pragma unroll
            for (int nt = 0; nt < 2; ++nt) { bwh[ks][nt] = *(const bf16x8*)(rwf + ((ks * 2 + nt) * 2048 + lo16)); bwl[ks][nt] = *(const bf16x8*)(rwf + ((ks * 2 + nt) * 2048 + 1024 + lo16)); } }
        __syncthreads();
        f32x4 acc[2] = {(f32x4){0.f, 0.f, 0.f, 0.f}, (f32x4){0.f, 0.f, 0.f, 0.f}};
#pragma unroll
        for (int ks = 0; ks < 8; ++ks) { const int off = fr * RS + (kb + 32 * ks + 8 * fq) * 2;
            const bf16x8 ah = *(const LAS bf16x8*)(HH + off), al = *(const LAS bf16x8*)(HL + off);
#pragma unroll
            for (int nt = 0; nt < 2; ++nt) { acc[nt] = __builtin_amdgcn_mfma_f32_16x16x32_bf16(ah, bwh[ks][nt], acc[nt], 0, 0, 0); acc[nt] = __builtin_amdgcn_mfma_f32_16x16x32_bf16(ah, bwl[ks][nt], acc[nt], 0, 0, 0);
                acc[nt] = __builtin_amdgcn_mfma_f32_16x16x32_bf16(al, bwh[ks][nt], acc[nt], 0, 0, 0); } }
        __syncthreads();
#pragma unroll
        for (int nt = 0; nt < 2; ++nt)
#pragma unroll
            for (int q = 0; q < 4; ++q) part[(c.wave * 16 + 4 * fq + q) * 32 + 16 * nt + fr] = acc[nt][q];
        __syncthreads();
        { const int t3 = c.wave * 64 + pg8::fresh_lane(), rr = t3 >> 5, ee = t3 & 31; float sacc = c.I(I_RB)[l * NE + ee];
#pragma unroll
          for (int w = 0; w < 8; ++w) sacc += part[(w * 16 + rr) * 32 + ee];
          logit[rr * 32 + ee] = sacc; }
        __syncthreads();
        {
            const int ln = pg8::fresh_lane(), hh = ln >> 5, ee = ln & 31, rl = c.wave * 2 + hh, r = r0 + rl;
            float mine = logit[rl * 32 + ee]; float tv[4]; int ti[4];
#pragma unroll
            for (int k = 0; k < 4; ++k) { float mx = mine; mx = fmaxf(mx, __shfl_xor(mx, 1)); mx = fmaxf(mx, __shfl_xor(mx, 2)); mx = fmaxf(mx, __shfl_xor(mx, 4)); mx = fmaxf(mx, __shfl_xor(mx, 8)); mx = fmaxf(mx, __shfl_xor(mx, 16));
                const unsigned long long bal = __ballot(mine == mx); const unsigned mybits = hh ? (unsigned)(bal >> 32) : (unsigned)bal; const int idx = __ffs((int)mybits) - 1; tv[k] = mx; ti[k] = idx; if (ee == idx) mine = -3e38f; }
            const float e1 = __expf(tv[1] - tv[0]), e2 = __expf(tv[2] - tv[0]), e3 = __expf(tv[3] - tv[0]), inv = 1.f / (1.f + e1 + e2 + e3);
            if (ee == 0) { *(int4*)(topi + (size_t)r * 4) = make_int4(ti[0], ti[1], ti[2], ti[3]); *(float4*)(gate + (size_t)r * 4) = make_float4(inv, e1 * inv, e2 * inv, e3 * inv); }
            if (ee < 4) { const int ex = ee == 0 ? ti[0] : ee == 1 ? ti[1] : ee == 2 ? ti[2] : ti[3]; __hip_atomic_fetch_add(lcnt + ex, 1, __ATOMIC_RELAXED, __HIP_MEMORY_SCOPE_WORKGROUP); }
        }
    }
    __syncthreads();
    { const int t2 = c.wave * 64 + (int)__builtin_amdgcn_mbcnt_hi(~0u, __builtin_amdgcn_mbcnt_lo(~0u, 0u));
      if (t2 < 32 && c.flag == 0) { const int n = lcnt[t2]; if (n) atomicAdd(cnt + t2 * 64, (unsigned)n); } }
}
__device__ __forceinline__ void moe_tables(const Ctx& c, int l, lint* tab) {
    const unsigned* cnt = c.ctl() + CW_CNT + l * 32 * 64;
    __syncthreads();
    if (c.tid < 32) tab[c.tid] = (int)__hip_atomic_load(cnt + c.tid * 64, __ATOMIC_RELAXED, __HIP_MEMORY_SCOPE_AGENT);
    __syncthreads();
    if (c.tid == 0) { int so = 0, to = 0; for (int e = 0; e < 32; ++e) { const int n = tab[e]; tab[32 + e] = so; tab[64 + e] = to; const int nt = (n + 255) >> 8; so += nt * 256; to += nt; } tab[96] = to; }
    __syncthreads();
    if (c.tid < 32) { const int t0 = tab[64 + c.tid], t1 = (c.tid == 31) ? tab[96] : tab[65 + c.tid]; for (int t = t0; t < t1; ++t) tab[128 + t] = c.tid; }
    __syncthreads();
}
__device__ __forceinline__ void ph_slots(const Ctx& c, int l) {
    lint* tab = (lint*)(c.lds + LDS_MISC);
    lint* lc = tab + 512;
    moe_tables(c, l, tab);
    const int total = ((l == 0) ? MT : TL) * 4;
    const int* topi = (const int*)(c.ws + WS_TOPI); int* tslot = (int*)(c.ws + WS_TSLOT); int* stok = (int*)(c.ws + WS_STOK);
    unsigned* fill = c.ctl() + CW_FILL + l * 32 * 64;
    for (int i0 = c.bid * 512; i0 < total; i0 += c.nb * 512) {
        const int i = i0 + c.tid;
        if (c.tid < 32) lc[c.tid] = 0;
        __syncthreads();
        int e = 0, pos = 0;
        if (i < total) { e = topi[i]; pos = __hip_atomic_fetch_add(lc + e, 1, __ATOMIC_RELAXED, __HIP_MEMORY_SCOPE_WORKGROUP); }
        __syncthreads();
        if (c.tid < 32) { const int n = lc[c.tid]; lc[32 + c.tid] = n ? (int)atomicAdd(fill + c.tid * 64, (unsigned)n) : 0; }
        __syncthreads();
        if (i < total) { const int slot = tab[32 + e] + lc[32 + e] + pos; tslot[i] = slot; stok[slot] = i >> 2; }
        __syncthreads();
    }
    if (c.bid == c.nb - 1) for (int e = 0; e < 32; ++e) { const int n = tab[e], s0 = tab[32 + e], np = ((n + 255) >> 8) << 8; for (int sidx = n + c.tid; sidx < np; sidx += 512) stok[s0 + sidx] = 0; }
}
__device__ __forceinline__ int tile_expert(const lint* tab, int tile) { return tab[128 + tile]; }
template <int KB> struct SchedMoe { const char* A; const int* stok; const char* Bt; const lint* tab; int G, c;
    __device__ __forceinline__ bool next(int i, Unit& u) const { const int L = i * G + c, nT = __builtin_amdgcn_readfirstlane(tab[96]); if (L >= nT * (D / 256)) return false; int pm, pn; pg8::tile_order(L, nT, D / 256, pm, pn); u.row0 = pm * 256; u.col0 = pn * 256;
        u.e = __builtin_amdgcn_readfirstlane(tile_expert(tab, pm)); return true; }
    __device__ __forceinline__ const char* a_base(const Unit& u) const { return stok ? A : A + (size_t)u.row0 * KB; }
    __device__ __forceinline__ const int* a_idx(const Unit& u) const { return stok + u.row0; }
    __device__ __forceinline__ const char* b_base(const Unit& u) const { return Bt + ((size_t)u.e * D + u.col0) * KB; }
};
struct EpiAct { static constexpr bool PERM = true; const float* b1; unsigned char* ACT8;
    __device__ __forceinline__ void operator()(const f32x4 (&acc)[2][2][4][2], const Unit& u, int wr, int wc, int fr, int fq) const {
        const int colb = u.col0 + wc * 32 + 8 * fq; const unsigned boff = (unsigned)(u.e * D + colb) * 4u;
#pragma unroll
        for (int bj = 0; bj < 2; ++bj) { const f32x4 b0 = *(const f32x4*)((const char*)b1 + (boff + bj * 512)), b1v = *(const f32x4*)((const char*)b1 + (boff + bj * 512 + 16));
#pragma unroll
            for (int ai = 0; ai < 2; ++ai)
#pragma unroll
                for (int m = 0; m < 4; ++m) { const int row = u.row0 + ai * 128 + wr * 64 + m * 16 + fr; const unsigned off = (unsigned)(row * DFF + (colb >> 1) + bj * 64);
                    const f32x4 v0 = acc[ai][bj][m][0] * (1.f / W8S) + b0, v1 = acc[ai][bj][m][1] * (1.f / W8S) + b1v;
                    *(unsigned*)(ACT8 + off) = pk4_fp8(swiglu_act(v0[0], v0[1]), swiglu_act(v0[2], v0[3]), swiglu_act(v1[0], v1[1]), swiglu_act(v1[2], v1[3])); } }
    }
};
struct EpiOS { static constexpr bool PERM = true; const float* b2; unsigned char* OS8;
    __device__ __forceinline__ void operator()(const f32x4 (&acc)[2][2][4][2], const Unit& u, int wr, int wc, int fr, int fq) const {
        const int colb = u.col0 + wc * 32 + 8 * fq; const unsigned boff = (unsigned)(u.e * D + colb) * 4u;
#pragma unroll
        for (int bj = 0; bj < 2; ++bj) { const f32x4 b0 = *(const f32x4*)((const char*)b2 + (boff + bj * 512)), b1v = *(const f32x4*)((const char*)b2 + (boff + bj * 512 + 16));
#pragma unroll
            for (int ai = 0; ai < 2; ++ai)
#pragma unroll
                for (int m = 0; m < 4; ++m) { const int row = u.row0 + ai * 128 + wr * 64 + m * 16 + fr; const unsigned off = (unsigned)(row * D + colb + bj * 128);
                    const f32x4 v0 = acc[ai][bj][m][0] * (1.f / W8S) + b0, v1 = acc[ai][bj][m][1] * (1.f / W8S) + b1v;
                    pg8::u32x2 w; w.x = pk4_fp8(v0[0], v0[1], v0[2], v0[3]); w.y = pk4_fp8(v1[0], v1[1], v1[2], v1[3]);
                    *(pg8::u32x2*)(OS8 + off) = w; } }
    }
};
__device__ __forceinline__ void ph_moe1(const Ctx& c, int l) {
    lint* tab = (lint*)(c.lds + LDS_MISC);
    moe_tables(c, l, tab);
    SchedMoe<D> S{(const char*)(c.ws + WS_H8), (const int*)(c.ws + WS_STOK), (const char*)(c.ws + WS_W1T) + (size_t)l * NE * D * D, tab, c.nb, c.bid};
    EpiAct E{c.I(I_B1) + (size_t)l * NE * D, c.ws + WS_ACT};
    pg8::gemm_phase<D, true, true>(c.lds, c.lds + LDS_IDX, S, E, c.tid);
}
__device__ __forceinline__ void ph_moe2(const Ctx& c, int l) {
    lint* tab = (lint*)(c.lds + LDS_MISC);
    moe_tables(c, l, tab);
    SchedMoe<DFF> S{(const char*)(c.ws + WS_ACT), nullptr, (const char*)(c.ws + WS_W2T) + (size_t)l * NE * D * DFF, tab, c.nb, c.bid};
    EpiOS E{c.I(I_B2) + (size_t)l * NE * D, c.ws + WS_OS};
    pg8::gemm_phase<DFF, false, true>(c.lds, c.lds + LDS_IDX, S, E, c.tid);
}
__device__ __forceinline__ void unpack8_fp8(const uint2 v, float (&f)[8]) {
    typedef float f2 __attribute__((ext_vector_type(2)));
    const f2 a = __builtin_amdgcn_cvt_pk_f32_fp8((int)v.x, false), b = __builtin_amdgcn_cvt_pk_f32_fp8((int)v.x, true), c2 = __builtin_amdgcn_cvt_pk_f32_fp8((int)v.y, false), d = __builtin_amdgcn_cvt_pk_f32_fp8((int)v.y, true);
    f[0] = a.x; f[1] = a.y; f[2] = b.x; f[3] = b.y; f[4] = c2.x; f[5] = c2.y; f[6] = d.x; f[7] = d.y;
}
__device__ __forceinline__ void ph_combine(const Ctx& c, int l) {
    const int rows = (l == 0) ? MT : TL;
    const char* X1 = (const char*)c.XA(); const char* OS = (const char*)(c.ws + WS_OS);
    const int* tslot = (const int*)(c.ws + WS_TSLOT); const float* gate = (const float*)(c.ws + WS_GATE);
    const int lane = c.lane;
    for (int r = c.bid * 8 + c.wave; r < rows; r += c.nb * 8) {
        const int4 sl = *(const int4*)(tslot + (size_t)r * 4); const float4 gt = *(const float4*)(gate + (size_t)r * 4);
        const char* m = (const char*)(c.mod() + (size_t)(l * 9 + mod_row(r)) * MODW + 5 * D);
        u32x4_t xv[4]; uint2 oa[4], ob[4], oc[4], od[4]; f32x4 g2a[4], g2b[4];
#pragma unroll
        for (int j = 0; j < 4; ++j) { const unsigned col = (unsigned)(j * 64 + lane) * 8u;
            xv[j] = *(const u32x4_t*)(X1 + ((unsigned)r * D + col) * 2u);
            oa[j] = *(const uint2*)(OS + ((unsigned)sl.x * D + col)); ob[j] = *(const uint2*)(OS + ((unsigned)sl.y * D + col)); oc[j] = *(const uint2*)(OS + ((unsigned)sl.z * D + col)); od[j] = *(const uint2*)(OS + ((unsigned)sl.w * D + col));
            g2a[j] = *(const f32x4*)(m + col * 4u); g2b[j] = *(const f32x4*)(m + col * 4u + 16u); }
        float v[4][8]; float ss = 0.f;
#pragma unroll
        for (int j = 0; j < 4; ++j) { float x1[8], fa[8], fb[8], fc[8], fd[8]; unpack8(xv[j], x1); unpack8_fp8(oa[j], fa); unpack8_fp8(ob[j], fb); unpack8_fp8(oc[j], fc); unpack8_fp8(od[j], fd);
#pragma unroll
            for (int i = 0; i < 8; ++i) { const float f = gt.x * fa[i] + gt.y * fb[i] + gt.z * fc[i] + gt.w * fd[i]; const float g2 = i < 4 ? g2a[j][i] : g2b[j][i - 4]; v[j][i] = x1[i] + g2 * f; ss += v[j][i] * v[j][i]; } }
        const float rstd = rsqrtf(wave_sum(ss) * (1.f / D) + EPS);
        if (l == 0) {
            const char* m1 = (const char*)(c.mod() + (size_t)(9 + mod_row(r)) * MODW); const char* g1n = (const char*)(c.I(I_N1G) + D);
#pragma unroll
            for (int jh = 0; jh < 2; ++jh) {
                f32x4 gg[2][2], sc[2][2], sh[2][2];
#pragma unroll
                for (int j2 = 0; j2 < 2; ++j2)
#pragma unroll
                    for (int q = 0; q < 2; ++q) { const unsigned co = ((unsigned)((jh * 2 + j2) * 64 + lane) * 8u + 4u * q) * 4u; gg[j2][q] = *(const f32x4*)(g1n + co); sc[j2][q] = *(const f32x4*)(m1 + (unsigned)(D * 4) + co); sh[j2][q] = *(const f32x4*)(m1 + co); }
#pragma unroll
                for (int j2 = 0; j2 < 2; ++j2) { const int j = jh * 2 + j2; const unsigned col = (unsigned)(j * 64 + lane) * 8u;
                    *(uint4*)((char*)c.XB() + ((unsigned)r * D + col) * 2u) = make_uint4(pk2(v[j][0], v[j][1]), pk2(v[j][2], v[j][3]), pk2(v[j][4], v[j][5]), pk2(v[j][6], v[j][7]));
                    float h[8];
#pragma unroll
                    for (int i = 0; i < 8; ++i) h[i] = v[j][i] * rstd * gg[j2][i >> 2][i & 3] * (1.f + sc[j2][i >> 2][i & 3]) + sh[j2][i >> 2][i & 3];
                    *(uint4*)((char*)c.H() + ((unsigned)r * D + col) * 2u) = make_uint4(pk2(h[0], h[1]), pk2(h[2], h[3]), pk2(h[4], h[5]), pk2(h[6], h[7])); }
                asm volatile("" ::: "memory");
            }
        } else {
            const char* fgp = (const char*)c.I(I_FG); f32x4 fg[4][2];
#pragma unroll
            for (int j = 0; j < 4; ++j)
#pragma unroll
                for (int q = 0; q < 2; ++q) fg[j][q] = *(const f32x4*)(fgp + ((unsigned)(j * 64 + lane) * 8u + 4u * q) * 4u);
#pragma unroll
            for (int j = 0; j < 4; ++j) { const unsigned col = (unsigned)(j * 64 + lane) * 8u; f32x4 o0, o1;
#pragma unroll
                for (int i = 0; i < 4; ++i) { o0[i] = v[j][i] * rstd * fg[j][0][i]; o1[i] = v[j][4 + i] * rstd * fg[j][1][i]; }
                *(f32x4*)((char*)c.out + ((unsigned)r * D + col) * 4u) = o0; *(f32x4*)((char*)c.out + (((unsigned)r * D + col) * 4u + 16u)) = o1; }
        }
    }
}

constexpr int PH_PER_LAYER = 10, N_PHASES = 2 + 2 * PH_PER_LAYER;
#ifndef REP_0
#define REP_0 1
#endif
#ifndef REP_1
#define REP_1 1
#endif
#ifndef REP_2
#define REP_2 1
#endif
#ifndef REP_3
#define REP_3 1
#endif
#ifndef REP_4
#define REP_4 1
#endif
#ifndef REP_7
#define REP_7 1
#endif
#ifndef REP_8
#define REP_8 1
#endif
#ifndef REP_9
#define REP_9 1
#endif
#ifndef PROBE_CVT
#define PROBE_CVT 1
#endif
#ifndef MK_N_LAUNCHES
#define MK_N_LAUNCHES 1
#endif
__global__ void __launch_bounds__(512, 2) mk_fwd(Params p) {
    extern __shared__ __attribute__((aligned(16))) unsigned char lds[];
    Ctx c; c.in = p.in; c.out = p.out; c.ws = p.ws; c.tid = threadIdx.x; c.lane = c.tid & 63; c.wave = __builtin_amdgcn_readfirstlane(c.tid >> 6); c.bid = blockIdx.x; c.nb = gridDim.x; c.flag = p.pad; c.lds = (LAS unsigned char*)lds;
    const int lo = p.ph_lo, hi = p.ph_hi;
    XcdBarrier bar;
    {
        unsigned* bw = c.ctl() + CW_BAR + p.li * XCD_BAR_WORDS;
        if (c.tid == 0) { *(volatile LAS unsigned*)(c.lds + LDS_XB) = 0u; *(volatile LAS unsigned*)(c.lds + LDS_XB + 4) = 0u; }
        __syncthreads();
        bar = xcd_barrier_post(bw, (volatile LAS unsigned*)(c.lds + LDS_XB));
        if (c.tid == 0 && hi - lo > 1) { unsigned nloc, nx; xcd_barrier_complete(bw, bar.x, nloc, nx); bar.st[0] = nloc; bar.st[1] = nx; }
        __syncthreads();
    }
#define FRESH() do { unsigned _z = 0u; asm volatile("" : "+v"(_z)); c.lane = (int)__builtin_amdgcn_mbcnt_hi(~0u, __builtin_amdgcn_mbcnt_lo(~0u, _z)); asm volatile("" : "+s"(c.bid)); asm volatile("" : "+s"(c.wave)); c.tid = c.wave * 64 + c.lane; } while (0)
#define FRESHL() do { FRESH(); asm volatile("" : "+s"(l)); } while (0)
#ifdef ONLYPH
#define IN(k) ((k) == ONLYPH)
#define INL(i) ((i) + 2 == ONLYPH)
#else
#define IN(k) (lo <= (k) && (k) < hi)
#define INL(i) IN(pb + (i))
#endif
#ifdef TPROBE
#define TSTAMP(k) do { if (c.wave == 0 && __builtin_amdgcn_mbcnt_hi(~0u, __builtin_amdgcn_mbcnt_lo(~0u, 0u)) == 0u) __hip_atomic_store(c.ctl() + CW_TS + (k) * 256 + c.bid, (unsigned)__builtin_amdgcn_s_memrealtime(), __ATOMIC_RELAXED, __HIP_MEMORY_SCOPE_AGENT); } while (0)
#else
#define TSTAMP(k) do { } while (0)
#endif
#define SEAM(k) do { TSTAMP(k); if ((k) + 1 < hi) xcd_barrier<false>(bar, c.wave); } while (0)
#define SEAM0() SEAM(0)
    TSTAMP(1);
    if (IN(0)) { FRESH(); ph_mod_full(c); FRESH(); ph_convert_lru(c); FRESH(); ph_convert_router(c); for (int rep = 0; rep < PROBE_CVT; ++rep) { FRESH(); ph_convert(c); } SEAM0(); }
    for (int l0 = 0; l0 < 2; ++l0) {
        int l = l0;
        const int pb = 2 + l0 * PH_PER_LAYER;
        if (INL(0) && l == 0) { for (int rep = 0; rep < REP_0; ++rep) { FRESHL(); ph_norm1(c, l); } SEAM(pb + 0); }
        if (INL(1)) {
            if (c.nb != 256 || c.bid < (l == 0 ? G_IN0 : G_IN1)) { for (int rep = 0; rep < REP_1; ++rep) { FRESHL(); ph_gemm_in(c, l); } }
            else { FRESHL(); if (l == 0) tail_convert(c, CVT_A + (c.bid - G_IN0) * Q_IN0, Q_IN0); else tail_convert(c, CVT_C + (c.bid - G_IN1) * Q_IN1, Q_IN1); }
            SEAM(pb + 1); }
#define DEAL(n_, off_) for (int it = (int)((unsigned)(c.bid + c.nb * 64 - (off_)) % (unsigned)c.nb); it < (n_); it += c.nb)
#define DEAL_FROM(n_, first_) for (int it = c.bid - (first_); it >= 0 && it < (n_); it += c.nb - (first_))
        if (INL(2)) {
            const int nLru = NB * NCHUNK, nA = (l == 0) ? MT / 32 : TL / 32;
            for (int rep = 0; rep < REP_2; ++rep) {
            FRESHL();
            DEAL(nLru, 0) lru::lru_item<0>(c, l, it / NCHUNK, it % NCHUNK);
            FRESHL();
            DEAL_FROM(nA, nLru % c.nb) conva_item(c, l, it);
            }
            SEAM(pb + 2);
        }
        if (INL(3)) {
            const int nAtt = NB * 4 * (SEQ / 256) + (l == 0 ? NB * 4 : 0), nLru = (l == 0) ? NB * NCHUNK : NB * (NCHUNK - NCC), nA = (l == 0) ? MT / 32 : TL / 32;
            for (int rep = 0; rep < REP_3; ++rep) { FRESHL(); ph_attention(c, l); }
            FRESHL();
            DEAL(nLru, nAtt) { const int per = (l == 0) ? NCHUNK : NCHUNK - NCC; lru::lru_item<1>(c, l, it / per, (l == 0 ? 0 : NCC) + it % per); }
            FRESHL();
            DEAL_FROM(nA, (l == 0) ? 64 : 0) convc_item(c, l, it);
            if (l == 0 && c.nb == 256 && c.bid >= MIX_FIRST) { FRESHL(); tail_convert(c, CVT_M + (c.bid - MIX_FIRST) * Q_MIX, Q_MIX); }
            SEAM(pb + 3);
        }
#undef DEAL
        if (INL(4)) {
            if (c.nb != 256 || l != 0 || c.bid < G_OUT0) { for (int rep = 0; rep < REP_4; ++rep) { FRESHL(); ph_gemm_out(c, l); } }
            else { FRESHL(); tail_convert(c, CVT_B + (c.bid - G_OUT0) * Q_OUT0, Q_OUT0); }
            SEAM(pb + 4); }
        if (INL(5)) { FRESHL(); ph_norm2_router(c, l); SEAM(pb + 5); }
        if (INL(6)) { FRESHL(); ph_slots(c, l); SEAM(pb + 6); }
        if (INL(7)) { for (int rep = 0; rep < REP_7; ++rep) { FRESHL(); ph_moe1(c, l); } SEAM(pb + 7); }
        if (INL(8)) { for (int rep = 0; rep < REP_8; ++rep) { FRESHL(); ph_moe2(c, l); } SEAM(pb + 8); }
        if (INL(9)) { for (int rep = 0; rep < REP_9; ++rep) { FRESHL(); ph_combine(c, l); } SEAM(pb + 9); }
    }
#ifdef TPROBE
    if (c.bid == 0 && c.wave == 0 && __builtin_amdgcn_mbcnt_hi(~0u, __builtin_amdgcn_mbcnt_lo(~0u, 0u)) == 0u) {
        unsigned* ts = c.ctl() + CW_TS;
        const unsigned t0 = xb_ld(ts + TP_K * 256);
        int mA = -(1 << 30), mB = -(1 << 30), mP = -(1 << 30);
        for (int b = 0; b < (int)c.nb; ++b) { const int d = (int)(xb_ld(ts + TP_K * 256 + b) - t0); if (b < TP_G) mA = d > mA ? d : mA; else mB = d > mB ? d : mB;
            const int dp = (int)(xb_ld(ts + TP_KP * 256 + b) - t0); mP = dp > mP ? dp : mP; }
        const int mAll = mA > mB ? mA : mB;
        int stat = 0;
        if (TP_MODE == 1) stat = mAll - mP;
        if (TP_MODE == 2) stat = mA - mB;
        if (TP_MODE == 3) stat = mB - mA;
        if (TP_MODE == 4) stat = mB - mA + TP_OFF;
        if (stat < 0) stat = 0;
        const unsigned long long tend = __builtin_amdgcn_s_memrealtime() + (unsigned long long)stat * TP_AMP;
        while (__builtin_amdgcn_s_memrealtime() < tend) __builtin_amdgcn_s_sleep(8);
    }
#endif
#undef IN
#undef INL
#undef SEAM
#undef SEAM0
#undef FRESH
#undef FRESHL
}

extern "C" void kernel_launch(void* const* d_in, const int* in_sizes, int n_in, void* d_out, int out_size, void* d_ws, size_t ws_size, hipStream_t stream) {
    static int grid = 0;
    if (grid == 0) {
        if (n_in != N_INPUTS || out_size != TL * D || ws_size < WS_END) { fprintf(stderr, "kernel_launch: unexpected shapes (n_in %d, out %d, ws %zu)\n", n_in, out_size, ws_size); grid = -1; return; }
        int dev = 0, cus = 0, per_cu = 0;
        if (hipGetDevice(&dev) != hipSuccess || hipDeviceGetAttribute(&cus, hipDeviceAttributeMultiprocessorCount, dev) != hipSuccess) { grid = -1; return; }
        if (hipFuncSetAttribute((const void*)mk_fwd, hipFuncAttributeMaxDynamicSharedMemorySize, LDS_BYTES) != hipSuccess) { fprintf(stderr, "kernel_launch: hipFuncSetAttribute failed\n"); grid = -1; return; }
        if (hipOccupancyMaxActiveBlocksPerMultiprocessor(&per_cu, (const void*)mk_fwd, 512, LDS_BYTES) != hipSuccess || per_cu < 1) { fprintf(stderr, "kernel_launch: occupancy query says %d workgroups per CU\n", per_cu); grid = -1; return; }
        grid = cus < 256 ? cus : 256;
    }
    if (grid < 0) return;
    (void)hipMemsetAsync((char*)d_ws + WS_CTL, 0, CTL_BYTES, stream);
    Params p{};
    for (int i = 0; i < N_INPUTS; ++i) p.in[i] = (const float*)d_in[i];
    p.out = (float*)d_out; p.ws = (unsigned char*)d_ws;
#ifdef PROBE_PHASE
    const int cuts[4] = {0, PROBE_PHASE + 1, PROBE_PHASE + 1, N_PHASES};
    for (int li = 0; li < 3; ++li) { p.ph_lo = (li == 1) ? PROBE_PHASE : cuts[li]; p.ph_hi = cuts[li + 1]; p.li = li; p.pad = (li == 1); if (li == 2) p.ph_lo = PROBE_PHASE + 1; if (p.ph_lo < p.ph_hi) hipLaunchKernelGGL(mk_fwd, dim3(grid), dim3(512), LDS_BYTES, stream, p); }
#else
    p.ph_lo = 0; p.ph_hi = N_PHASES; p.li = 0;
    hipLaunchKernelGGL(mk_fwd, dim3(grid), dim3(512), LDS_BYTES, stream, p);
#endif
}
```
